# Optimizing an MI355X kernel written in HIP

```python
import math
import jax, jax.numpy as jnp
from jax import lax
import numpy as np

D_MODEL = 1024
BATCH = 2
SEQ = 8192
DEPTH = 4

N_MIXERS = 4
DN_ALPHA = (2.0 * DEPTH) ** 0.25
DN_BETA = (8.0 * DEPTH) ** -0.25
LN_EPS = 1e-5

GDN_HEADS = 8
GDN_DK = D_MODEL // GDN_HEADS
GDN_DV = D_MODEL // GDN_HEADS
GDN_CONV = 4
GDN_CHUNK = 64
RET_HEADS = 4
RET_DK = D_MODEL // RET_HEADS
RET_DV = 2 * D_MODEL // RET_HEADS
RET_CHUNK = 128
RET_ROPE_BASE = 10000.0
GMLP_CHUNK = 128
GMLP_WIDTH = 2 * D_MODEL
GMLP_GROUPS = 8
SB_HEADS = 16
SB_DH = D_MODEL // SB_HEADS
SB_BLOCK = 128
FFN_HIDDEN = ((8 * D_MODEL // 3 + 255) // 256) * 256
FFN_CONV = 3

kernel_name = 'hybrid_interleaved_gdn_ret_gmlp_sb_trunk'

F32 = jnp.float32


def _standardize(x, eps):
    xf = x.astype(F32)
    mu = jnp.mean(xf, axis=-1, keepdims=True)
    xc = xf - mu
    var = jnp.mean(xc * xc, axis=-1, keepdims=True)
    return xc * lax.rsqrt(var + eps)


def layer_norm(x, g, b):
    return (_standardize(x, LN_EPS) * g.astype(F32) + b.astype(F32)).astype(x.dtype)


def _l2norm(x, eps=1e-6):
    return x * lax.rsqrt(jnp.sum(x * x, axis=-1, keepdims=True) + eps)


def causal_dwconv(x, w):
    k_w = w.shape[0]
    s = x.shape[1]
    xp = jnp.pad(x, ((0, 0), (k_w - 1, 0), (0, 0)))
    y = xp[:, k_w - 1:k_w - 1 + s] * w[k_w - 1]
    for j in range(k_w - 1):
        y = y + xp[:, j:j + s] * w[j]
    return y


def _chunk_heads(t, n_heads, chunk):
    b, s, hd = t.shape
    return t.astype(F32).reshape(b, s // chunk, chunk, n_heads, hd // n_heads).transpose(0, 3, 1, 2, 4)


def _unchunk_heads(t):
    b, h, n, c, d = t.shape
    return t.transpose(0, 2, 3, 1, 4).reshape(b, n * c, h, d)


def gated_deltanet(h, w_in, conv_w, a_log, dt_bias, norm_w, w_out):
    H, dk, dv, C = GDN_HEADS, GDN_DK, GDN_DV, GDN_CHUNK
    b_, s, _ = h.shape
    n_qkv = 2 * H * dk + H * dv
    proj = h @ w_in
    qkv, z, a, bt = jnp.split(proj, [n_qkv, n_qkv + H * dv, n_qkv + H * dv + H], axis=-1)
    qkv = jax.nn.silu(causal_dwconv(qkv, conv_w))
    q, k, v = jnp.split(qkv, [H * dk, 2 * H * dk], axis=-1)
    q = _l2norm(_chunk_heads(q, H, C)) * (dk ** -0.5)
    k = _l2norm(_chunk_heads(k, H, C))
    v = _chunk_heads(v, H, C)
    beta = jax.nn.sigmoid(_chunk_heads(bt, H, C)[..., 0])
    g = -jnp.exp(a_log.astype(F32))[:, None, None] * jax.nn.softplus(
        _chunk_heads(a, H, C)[..., 0] + dt_bias.astype(F32)[:, None, None])
    gc = jnp.cumsum(g, axis=-1)
    idx = jnp.arange(C)
    causal = idx[:, None] >= idx[None, :]
    strict = idx[:, None] > idx[None, :]
    diff = gc[..., :, None] - gc[..., None, :]
    decay = jnp.where(causal, jnp.exp(jnp.where(causal, diff, 0.0)), 0.0)
    kb = k * beta[..., None]
    kk = jnp.where(strict, jnp.einsum('bhncd,bhnmd->bhncm', kb, k) * decay, 0.0)
    eye = jnp.eye(C, dtype=F32)
    rhs = jnp.concatenate([v * beta[..., None], kb * jnp.exp(gc)[..., None]], axis=-1)
    sol = lax.linalg.triangular_solve(kk + eye, rhs, left_side=True, lower=True, unit_diagonal=True)
    u, w = sol[..., :dv], sol[..., dv:]
    qk = jnp.where(causal, jnp.einsum('bhncd,bhnmd->bhncm', q, k) * decay, 0.0)

    def step(state, inp):
        q_n, k_n, u_n, w_n, qk_n, g_n = inp
        v_new = u_n - jnp.einsum('bhck,bhkv->bhcv', w_n, state)
        o = (jnp.einsum('bhck,bhkv->bhcv', q_n * jnp.exp(g_n)[..., None], state)
             + jnp.einsum('bhcm,bhmv->bhcv', qk_n, v_new))
        g_last = g_n[..., -1:]
        state = (state * jnp.exp(g_last)[..., None]
                 + jnp.einsum('bhck,bhcv->bhkv', k_n * jnp.exp(g_last - g_n)[..., None], v_new))
        return state, o

    xs = tuple(jnp.moveaxis(t, 2, 0) for t in (q, k, u, w, qk, gc))
    state0 = jnp.zeros((b_, H, dk, dv), F32)
    _, o = lax.scan(step, state0, xs)
    o = _unchunk_heads(jnp.moveaxis(o, 0, 2))
    o = o * lax.rsqrt(jnp.mean(o * o, axis=-1, keepdims=True) + 1e-6) * norm_w.astype(F32)
    o = o * jax.nn.silu(z.astype(F32).reshape(b_, s, H, dv))
    return o.reshape(b_, s, H * dv).astype(h.dtype) @ w_out


def retention(h, w_in, w_out):
    H, dk, dv, C = RET_HEADS, RET_DK, RET_DV, RET_CHUNK
    b_, s, _ = h.shape
    q, k, v, gate = jnp.split(h @ w_in, [H * dk, 2 * H * dk, 2 * H * dk + H * dv], axis=-1)
    pos = jnp.arange(s, dtype=F32)
    inv_freq = RET_ROPE_BASE ** (-jnp.linspace(0.0, 1.0, dk // 2, dtype=F32))
    ang = pos[:, None] * inv_freq[None, :]
    cos_a, sin_a = jnp.cos(ang)[:, None, :], jnp.sin(ang)[:, None, :]

    def rot(t):
        t = t.astype(F32).reshape(b_, s, H, dk)
        t1, t2 = t[..., :dk // 2], t[..., dk // 2:]
        return jnp.concatenate([t1 * cos_a - t2 * sin_a, t1 * sin_a + t2 * cos_a], axis=-1).reshape(b_, s, H * dk)

    q = _chunk_heads(rot(q), H, C)
    k = _chunk_heads(rot(k), H, C) * (dk ** -0.5)
    v = _chunk_heads(v, H, C)
    log_gamma = jnp.log(1.0 - jnp.power(2.0, -5.0 - jnp.arange(H, dtype=F32)))
    idx = jnp.arange(C, dtype=F32)
    rel = idx[:, None] - idx[None, :]
    dmask = jnp.where(rel >= 0, jnp.exp(jnp.maximum(rel, 0.0) * log_gamma[:, None, None]), 0.0)
    scores = jnp.einsum('bhncd,bhnmd->bhncm', q, k) * dmask[None, :, None]
    intra = jnp.einsum('bhncm,bhnmv->bhncv', scores, v)
    zeta = jnp.exp((C - 1.0 - idx)[None, :] * log_gamma[:, None])
    xi = jnp.exp((idx + 1.0)[None, :] * log_gamma[:, None])
    gamma_c = jnp.exp(C * log_gamma)

    def step(state, inp):
        q_n, k_n, v_n = inp
        o = jnp.einsum('bhck,bhkv->bhcv', q_n, state) * xi[None, :, :, None]
        state = (state * gamma_c[None, :, None, None]
                 + jnp.einsum('bhck,bhcv->bhkv', k_n * zeta[None, :, :, None], v_n))
        return state, o

    xs = tuple(jnp.moveaxis(t, 2, 0) for t in (q, k, v))
    _, inter = lax.scan(step, jnp.zeros((b_, H, dk, dv), F32), xs)
    o = _unchunk_heads(intra + jnp.moveaxis(inter, 0, 2))
    o = _standardize(o, 1e-6).reshape(b_, s, H * dv)
    o = o * jax.nn.silu(gate.astype(F32))
    return o.astype(h.dtype) @ w_out


def chunked_gmlp(h, w_in, ln_g, ln_b, w_s, b_s, w_out):
    C, G, W = GMLP_CHUNK, GMLP_GROUPS, GMLP_WIDTH
    b_, s, _ = h.shape
    u, v = jnp.split(jax.nn.gelu(h @ w_in, approximate=False), 2, axis=-1)
    v = layer_norm(v, ln_g, ln_b).reshape(b_, s // C, C, G, W // G)
    causal = jnp.tril(jnp.ones((C, C), dtype=bool))
    ws = jnp.where(causal, w_s, 0.0).astype(v.dtype)
    vs = jnp.einsum('gts,bnsgd->bntgd', ws, v) + b_s.T.astype(v.dtype)[None, None, :, :, None]
    return (u * vs.reshape(b_, s, W)) @ w_out


def stick_breaking(h, w_in, w_out):
    H, dh, T = SB_HEADS, SB_DH, SB_BLOCK
    b_, s, _ = h.shape
    nb = s // T
    q, k, v = jnp.split(h @ w_in, 3, axis=-1)
    q, k, v = (t.reshape(b_, s, H, dh).transpose(0, 2, 1, 3) for t in (q, k, v))
    qb = q.reshape(b_, H, nb, T, dh).transpose(2, 0, 1, 3, 4)
    key_pos = jnp.arange(s)
    scale = dh ** -0.5

    def block(args):
        q_blk, blk = args
        z = jnp.einsum('bhtd,bhsd->bhts', q_blk, k).astype(F32) * scale
        q_pos = blk * T + jnp.arange(T)
        strict = key_pos[None, :] < q_pos[:, None]
        log_1mb = jnp.where(strict, jax.nn.log_sigmoid(-z), 0.0)
        after = lax.cumsum(log_1mb, axis=3, reverse=True) - log_1mb
        a = jnp.where(strict, jnp.exp(jax.nn.log_sigmoid(z) + after), 0.0)
        return jnp.einsum('bhts,bhsd->bhtd', a.astype(v.dtype), v)

    o = lax.map(block, (qb, jnp.arange(nb)))
    o = o.transpose(1, 0, 3, 2, 4).reshape(b_, s, H * dh)
    return o @ w_out


def conv_ffn(h, w_up, conv_w, conv_b, w_down):
    gate, up = jnp.split(h @ w_up, 2, axis=-1)
    gate = causal_dwconv(gate, conv_w) + conv_b
    return (jax.nn.silu(gate) * up) @ w_down


def setup_inputs(seed: int = 0) -> dict:
    key = jax.random.key(seed)
    ks = jax.random.split(key, 32)
    D, F = D_MODEL, FFN_HIDDEN

    def nrm(i, shape, scale):
        return jax.random.normal(ks[i], shape, F32) * scale

    gdn_qkv = 2 * GDN_HEADS * GDN_DK + GDN_HEADS * GDN_DV
    gdn_in = gdn_qkv + GDN_HEADS * GDN_DV + 2 * GDN_HEADS
    ret_in = 2 * RET_HEADS * RET_DK + 2 * RET_HEADS * RET_DV
    a_vals = jax.random.uniform(ks[14], (GDN_HEADS,), F32, 1.0, 16.0)
    dt = jnp.exp(jax.random.uniform(ks[15], (GDN_HEADS,), F32, math.log(1e-3), math.log(1e-1)))
    return {
        'x': nrm(0, (BATCH, SEQ, D), 1.0),
        'c': nrm(1, (BATCH, D), 1.0),
        'cond_w': nrm(2, (D, D), D ** -0.5),
        'cond_b': nrm(3, (D,), 0.01),
        'ada_w': nrm(4, (DEPTH, D, 6 * D), 0.1 * D ** -0.5),
        'ada_b': nrm(5, (DEPTH, 6 * D), 0.01),
        'ln_g': 1.0 + nrm(6, (DEPTH, 2, D), 0.02),
        'ln_b': nrm(7, (DEPTH, 2, D), 0.02),
        'ffn_up': nrm(8, (DEPTH, D, 2 * F), D ** -0.5),
        'ffn_conv_w': nrm(9, (DEPTH, FFN_CONV, F), FFN_CONV ** -0.5),
        'ffn_conv_b': nrm(10, (DEPTH, F), 0.01),
        'ffn_down': nrm(11, (DEPTH, F, D), DN_BETA * F ** -0.5),
        'gdn_w_in': nrm(12, (D, gdn_in), D ** -0.5),
        'gdn_conv_w': nrm(13, (GDN_CONV, gdn_qkv), GDN_CONV ** -0.5),
        'gdn_a_log': jnp.log(a_vals),
        'gdn_dt_bias': dt + jnp.log(-jnp.expm1(-dt)),
        'gdn_norm_w': 1.0 + nrm(16, (GDN_DV,), 0.02),
        'gdn_w_out': nrm(17, (GDN_HEADS * GDN_DV, D), DN_BETA * (GDN_HEADS * GDN_DV) ** -0.5),
        'ret_w_in': nrm(18, (D, ret_in), D ** -0.5),
        'ret_w_out': nrm(19, (RET_HEADS * RET_DV, D), DN_BETA * (RET_HEADS * RET_DV) ** -0.5),
        'gmlp_w_in': nrm(20, (D, 2 * GMLP_WIDTH), D ** -0.5),
        'gmlp_ln_g': 1.0 + nrm(21, (GMLP_WIDTH,), 0.02),
        'gmlp_ln_b': nrm(22, (GMLP_WIDTH,), 0.02),
        'gmlp_w_s': nrm(23, (GMLP_GROUPS, GMLP_CHUNK, GMLP_CHUNK), GMLP_CHUNK ** -0.5),
        'gmlp_b_s': 1.0 + nrm(24, (GMLP_GROUPS, GMLP_CHUNK), 0.01),
        'gmlp_w_out': nrm(25, (GMLP_WIDTH, D), DN_BETA * GMLP_WIDTH ** -0.5),
        'sb_w_in': nrm(26, (D, 3 * D), D ** -0.5),
        'sb_w_out': nrm(27, (D, D), DN_BETA * D ** -0.5),
    }


def reference(x, c, cond_w, cond_b, ada_w, ada_b, ln_g, ln_b, ffn_up, ffn_conv_w, ffn_conv_b, ffn_down,
              gdn_w_in, gdn_conv_w, gdn_a_log, gdn_dt_bias, gdn_norm_w, gdn_w_out,
              ret_w_in, ret_w_out,
              gmlp_w_in, gmlp_ln_g, gmlp_ln_b, gmlp_w_s, gmlp_b_s, gmlp_w_out,
              sb_w_in, sb_w_out):
    mixers = (
        lambda t: gated_deltanet(t, gdn_w_in, gdn_conv_w, gdn_a_log, gdn_dt_bias, gdn_norm_w, gdn_w_out),
        lambda t: retention(t, ret_w_in, ret_w_out),
        lambda t: chunked_gmlp(t, gmlp_w_in, gmlp_ln_g, gmlp_ln_b, gmlp_w_s, gmlp_b_s, gmlp_w_out),
        lambda t: stick_breaking(t, sb_w_in, sb_w_out),
    )
    e = jax.nn.silu(c @ cond_w + cond_b)
    for i in range(DEPTH):
        mod = (e @ ada_w[i] + ada_b[i])[:, None, :]
        sh1, sc1, g1, sh2, sc2, g2 = jnp.split(mod, 6, axis=-1)
        y = mixers[i % N_MIXERS](x * (1.0 + sc1) + sh1)
        x = layer_norm(DN_ALPHA * x + (1.0 + g1) * y, ln_g[i, 0], ln_b[i, 0])
        y = conv_ffn(x * (1.0 + sc2) + sh2, ffn_up[i], ffn_conv_w[i], ffn_conv_b[i], ffn_down[i])
        x = layer_norm(DN_ALPHA * x + (1.0 + g2) * y, ln_g[i, 1], ln_b[i, 1])
    return x
```

```cpp
#include <hip/hip_runtime.h>
#include <hip/hip_cooperative_groups.h>
#include <cstdio>
#include <cstdint>
namespace cg = cooperative_groups;

typedef unsigned short bf16_t;
typedef short bf16x8 __attribute__((ext_vector_type(8)));
typedef float f32x4 __attribute__((ext_vector_type(4)));
typedef unsigned u32x4 __attribute__((ext_vector_type(4)));

#define MIB (1024ull * 1024ull)
#ifndef REP_SYNC
#define REP_SYNC 1
#endif
#ifndef REP_F2
#define REP_F2 1
#endif
#ifndef REP_P0
#define REP_P0 1
#endif
#ifndef REP_GB
#define REP_GB 1
#endif
#ifndef REP_GD
#define REP_GD 1
#endif
#ifndef REP_SB
#define REP_SB 1
#endif
#ifndef REP_GLN
#define REP_GLN 1
#endif
#ifndef REP_LN
#define REP_LN 1
#endif
#ifndef REP_CONV
#define REP_CONV 1
#endif
#define GSYNC do { for (int r_ = 0; r_ < REP_SYNC; ++r_) xcd_barrier(xb); } while (0)
#ifndef F1_DUMMY
#define F1_DUMMY 0
#endif
#ifndef GEMM_BIG
#define GEMM_BIG gemm256
#endif
#ifndef REP_E
#define REP_E 1
#endif
#ifndef REP_F1
#define REP_F1 1
#endif
constexpr size_t OFF_WTMIX = 0;
constexpr size_t OFF_WTFFN = 16 * MIB;
constexpr size_t OFF_SMALL = 33 * MIB;
constexpr size_t OFF_COS = 34 * MIB;
constexpr size_t OFF_SIN = 38 * MIB;
constexpr size_t OFF_PRE = 42 * MIB;
constexpr size_t OFF_XM = 106 * MIB;
constexpr size_t OFF_SCR = 138 * MIB;
constexpr size_t WS_NEED = 378 * MIB;


#define XB_TMO      128
#define XB_XCNT(j)  (256  + 64 * (j))
#define XB_XSUB(j)  (1280 + 64 * (j))
#define XB_XGEN(j)  (2304 + 64 * (j))
#define XB_TOP      3328
#define XB_TOPGEN   3392
#define XCD_BAR_WORDS 3456
#define XB_SPIN_CAP (1u << 20)
#define LAS __attribute__((address_space(3)))
__device__ __forceinline__ unsigned xb_ld(unsigned* p) { return __hip_atomic_load(p, __ATOMIC_RELAXED, __HIP_MEMORY_SCOPE_AGENT); }
__device__ __forceinline__ unsigned xb_add(unsigned* p, unsigned v) { return __hip_atomic_fetch_add(p, v, __ATOMIC_RELAXED, __HIP_MEMORY_SCOPE_AGENT); }
__device__ __forceinline__ unsigned xb_xcc_id() { return (unsigned)__builtin_amdgcn_s_getreg((3 << 11) | 20) & 0xFu; }
#define XB_SPIN(cond, bar) do { unsigned _sp = 0; while (cond) { __builtin_amdgcn_s_sleep(1); \
    if ((++_sp & 255u) == 0u) { if (xb_ld(&(bar)[XB_TMO])) break; if (_sp > XB_SPIN_CAP) { atomicAdd(&(bar)[XB_TMO], 1u); break; } } } } while (0)
struct XcdBarrier { unsigned* bar; unsigned x; volatile LAS unsigned* st; };
__device__ __forceinline__ XcdBarrier xcd_barrier_post(unsigned* bar, volatile LAS unsigned* st) {
    XcdBarrier b; b.bar = bar; b.x = xb_xcc_id(); b.st = st;
    if (threadIdx.x == 0) (void)xb_add(&bar[XB_XCNT(b.x)], 1u);
    return b;
}
__device__ __forceinline__ void xcd_barrier_complete(unsigned* bar, unsigned x, unsigned& nloc, unsigned& nx) {
    const unsigned G = gridDim.x * gridDim.y * gridDim.z;
    unsigned sum, cnt, mine, sp = 0u;
    for (;;) {
        sum = 0u; cnt = 0u; mine = 0u;
#pragma unroll
        for (unsigned j = 0; j < 16; ++j) { const unsigned c = xb_ld(&bar[XB_XCNT(j)]); sum += c; cnt += (c > 0u) ? 1u : 0u; mine = (j == x) ? c : mine; }
        if (sum == G) break;
        __builtin_amdgcn_s_sleep(1);
        if ((++sp & 255u) == 0u) { if (xb_ld(&bar[XB_TMO])) break; if (sp > XB_SPIN_CAP) { atomicAdd(&bar[XB_TMO], 1u); break; } }
    }
    nloc = mine > 0u ? mine : 1u; nx = cnt > 0u ? cnt : 1u;
}
__device__ __forceinline__ void xcd_barrier(const XcdBarrier& b) {
    asm volatile("s_waitcnt vmcnt(0)" ::: "memory");
    __syncthreads();
    if (threadIdx.x == 0) {
        unsigned* bar = b.bar;
        __builtin_amdgcn_s_waitcnt(0);
        unsigned nloc = b.st[0], nx = b.st[1];
        if (nloc == 0u) { xcd_barrier_complete(bar, b.x, nloc, nx); b.st[0] = nloc; b.st[1] = nx; }
        const unsigned old = xb_add(&bar[XB_XSUB(b.x)], 1u);
        const unsigned gen = old / nloc;
        if (old + 1u == (gen + 1u) * nloc) {
            __builtin_amdgcn_fence(__ATOMIC_RELEASE, "agent");
            asm volatile("s_waitcnt vmcnt(0)" ::: "memory");
            const unsigned og = xb_add(&bar[XB_TOP], 1u);
            const unsigned tg = og / nx;
            if (og + 1u == (tg + 1u) * nx) xb_add(&bar[XB_TOPGEN], 1u);
            else XB_SPIN(xb_ld(&bar[XB_TOPGEN]) == tg, bar);
            __builtin_amdgcn_fence(__ATOMIC_ACQUIRE, "agent");
            xb_add(&bar[XB_XGEN(b.x)], 1u);
            asm volatile("s_waitcnt vmcnt(0)" ::: "memory");
        } else {
            XB_SPIN(xb_ld(&bar[XB_XGEN(b.x)]) == gen, bar);
            __builtin_amdgcn_fence(__ATOMIC_ACQUIRE, "agent");
            asm volatile("s_waitcnt vmcnt(0)" ::: "memory");
        }
    }
    __syncthreads();
}
constexpr size_t OFF_BAR = 33 * MIB + 768 * 1024;
constexpr size_t OFF_STATS = 33 * MIB + 832 * 1024;

#define LOCAL_TID                                   \
    int tid = threadIdx.x;                          \
    asm volatile("" : "+v"(tid));                   \
    const int lane = tid & 63;                      \
    const int wv = __builtin_amdgcn_readfirstlane(tid >> 6); \
    (void)lane; (void)wv;

constexpr int TOK = 16384;
constexpr int SEQ = 8192;
constexpr float DN_ALPHA = 1.681792830507429f;

struct P {
    const float *x, *c, *cond_w, *cond_b, *ada_w, *ada_b, *ln_g, *ln_b, *ffn_up, *ffn_conv_w, *ffn_conv_b, *ffn_down;
    const float *gdn_w_in, *gdn_conv_w, *gdn_a_log, *gdn_dt_bias, *gdn_norm_w, *gdn_w_out, *ret_w_in, *ret_w_out;
    const float *gmlp_w_in, *gmlp_ln_g, *gmlp_ln_b, *gmlp_w_s, *gmlp_b_s, *gmlp_w_out, *sb_w_in, *sb_w_out;
    float* out;
    char* ws;
};

__device__ __forceinline__ float bf2f(bf16_t v) { return __uint_as_float(((unsigned)v) << 16); }
__device__ __forceinline__ bf16_t f2bf(float f) {
    unsigned u = __float_as_uint(f);
    u += 0x7fffu + ((u >> 16) & 1u);
    return (bf16_t)(u >> 16);
}
__device__ __forceinline__ unsigned pack2(float a, float b) { return (unsigned)f2bf(a) | ((unsigned)f2bf(b) << 16); }
__device__ __forceinline__ uint2 pack4(f32x4 v) { uint2 r; r.x = pack2(v[0], v[1]); r.y = pack2(v[2], v[3]); return r; }
__device__ __forceinline__ float lo16(unsigned u) { return __uint_as_float(u << 16); }
__device__ __forceinline__ float hi16(unsigned u) { return __uint_as_float(u & 0xffff0000u); }
__device__ __forceinline__ float wsum(float v) {
#pragma unroll
    for (int o = 32; o > 0; o >>= 1) v += __shfl_xor(v, o);
    return v;
}
__device__ __forceinline__ float wmax(float v) {
#pragma unroll
    for (int o = 32; o > 0; o >>= 1) v = fmaxf(v, __shfl_xor(v, o));
    return v;
}
__device__ __forceinline__ float silu_f(float x) { return x / (1.f + __expf(-x)); }
__device__ __forceinline__ float sigmoid_f(float x) { return 1.f / (1.f + __expf(-x)); }
__device__ __forceinline__ float gelu_f(float v) {
    const float av = fabsf(v), d = av * 0.2316418882f + 1.0f;
    const float t = __builtin_amdgcn_rcpf(d);
    float q = t * 0.5307027145f + (-0.7265760135f);
    q = q * t + 0.7107068705f; q = q * t + (-0.142248368f); q = q * t + 0.127414796f; q = q * t;
    const float e = __builtin_amdgcn_exp2f((v * v) * (-0.72134752044f));
    const float m = v * (q * e);
    return v < 0.f ? m : v - m;
}
__device__ __forceinline__ float softplus_f(float x) { return fmaxf(x, 0.f) + log1pf(__expf(-fabsf(x))); }
__device__ __forceinline__ f32x4 mfma16(bf16x8 a, bf16x8 b, f32x4 c) { return __builtin_amdgcn_mfma_f32_16x16x32_bf16(a, b, c, 0, 0, 0); }

__device__ __forceinline__ int ret_perm(int n) {
    if (n >= 2048) return n;
    int hb = n & ~255, pl = n & 255, kq = pl >> 5, e = pl & 31;
    return hb + (e < 16 ? 16 * kq + e : 128 + 16 * kq + (e - 16));
}
__device__ __forceinline__ int ffn_perm(int n) {
    const int ch = (n >> 7) * 64 + ((n >> 6) & 1) * 32 + (n & 31);
    return (n & 32) ? 2816 + ch : ch;
}
__device__ __forceinline__ void conv_job(const float* __restrict__ src, int K, int N, bf16_t* __restrict__ dst, int Np, int mode, char* smem) {
    float* lds = (float*)smem;
    int tid = threadIdx.x;
    asm volatile("" : "+v"(tid));
    const int ntn = Np >> 6, nkt = K >> 6, total = ntn * nkt;
    for (int rep = 0; rep < REP_CONV; ++rep)
    for (int t = blockIdx.x; t < total; t += gridDim.x) {
        const int nt = t % ntn, kt = t / ntn, n0 = nt * 64, k0 = kt * 64;
        __syncthreads();
        {
            const int n = tid & 63, ng = n0 + n;
            const int sc = (mode == 1) ? ret_perm(ng) : (mode == 2) ? ffn_perm(ng) : ng;
            const bool ok = sc < N;
#pragma unroll
            for (int i = 0; i < 16; ++i) {
                const int k = i * 4 + (tid >> 6);
                lds[k * 65 + n] = ok ? src[(size_t)(k0 + k) * N + sc] : 0.f;
            }
        }
        __syncthreads();
        {
#pragma unroll
            for (int i = 0; i < 2; ++i) {
                const int id = tid + i * 256, n = id >> 3, k8 = (id & 7) * 8;
                u32x4 o;
                o[0] = pack2(lds[(k8 + 0) * 65 + n], lds[(k8 + 1) * 65 + n]);
                o[1] = pack2(lds[(k8 + 2) * 65 + n], lds[(k8 + 3) * 65 + n]);
                o[2] = pack2(lds[(k8 + 4) * 65 + n], lds[(k8 + 5) * 65 + n]);
                o[3] = pack2(lds[(k8 + 6) * 65 + n], lds[(k8 + 7) * 65 + n]);
                *(u32x4*)(dst + (size_t)(n0 + n) * K + k0 + k8) = o;
            }
        }
    }
}

__device__ __forceinline__ void convert_layer(const P& p, int l, char* smem, int which  ) {
    bf16_t* WTM = (bf16_t*)(p.ws + OFF_WTMIX);
    bf16_t* WTF = (bf16_t*)(p.ws + OFF_WTFFN);
    const float* win = l == 0 ? p.gdn_w_in : l == 1 ? p.ret_w_in : l == 2 ? p.gmlp_w_in : p.sb_w_in;
    const float* wout = l == 0 ? p.gdn_w_out : l == 1 ? p.ret_w_out : l == 2 ? p.gmlp_w_out : p.sb_w_out;
    const int nin = l == 0 ? 4112 : l == 1 ? 6144 : l == 2 ? 4096 : 3072;
    const int npin = l == 0 ? 4224 : nin;
    const int kout = (l == 1 || l == 2) ? 2048 : 1024;
    if (which & 1) {
        conv_job(win, 1024, nin, WTM, npin, l == 1 ? 1 : 0, smem);
        conv_job(wout, kout, 1024, WTM + (size_t)npin * 1024, 1024, 0, smem);
    }
    if (which & 2) {
        conv_job(p.ffn_up + (size_t)l * 1024 * 5632, 1024, 5632, WTF, 5632, 2, smem);
        conv_job(p.ffn_down + (size_t)l * 2816 * 1024, 2816, 1024, WTF + 5632 * 1024, 1024, 0, smem);
    }
}

struct GA {
    const bf16_t *A, *B, *A2, *B2;
    long lda, ldb, lda2, ldb2;
    long a_o, a_i, b_o, b_i, a2_o, a2_i, b2_o, b2_i;
    int bdiv, M, N, K, K2, nbatch;
};
__device__ __forceinline__ GA ga_make(const bf16_t* A, long lda, const bf16_t* B, long ldb, int M, int N, int K) {
    GA g;
    g.A = A; g.B = B; g.A2 = A; g.B2 = B; g.lda = lda; g.ldb = ldb; g.lda2 = lda; g.ldb2 = ldb;
    g.a_o = g.a_i = g.b_o = g.b_i = g.a2_o = g.a2_i = g.b2_o = g.b2_i = 0;
    g.bdiv = 1; g.M = M; g.N = N; g.K = K; g.K2 = 0; g.nbatch = 1;
    return g;
}

template <int GBK, class Epi, int MODE = 0>
__device__ __forceinline__ void gemm_phase_t(const GA& g, Epi epi, char* smem) {
    constexpr int LDT = GBK + 8, GNCH = GBK / 8, GRPP = 256 / GNCH, GNLD = 128 / GRPP;
    int tid = threadIdx.x;
    asm volatile("" : "+v"(tid));
    const int lane = tid & 63, w = __builtin_amdgcn_readfirstlane(tid >> 6), wm = w >> 1, wn = w & 1;
    const int tm = g.M >> 7, tn = g.N >> 7, per = tm * tn, total = per * g.nbatch;
    const int nk1 = g.K / GBK, nk = nk1 + g.K2 / GBK;
    const int fr = lane & 15, fq = lane >> 4;
    char* const lw = smem + ((tid / GNCH) * LDT + (tid % GNCH) * 8) * 2;
    const char* const lra = smem + ((wm * 64 + fr) * LDT + fq * 8) * 2;
    const char* const lrb = smem + 128 * LDT * 2 + ((wn * 64 + fr) * LDT + fq * 8) * 2;
    for (int t = blockIdx.x; t < total; t += gridDim.x) {
        const int bt = t / per, idx = t - bt * per;
        const int grp = idx / (8 * tn), rem = idx - grp * 8 * tn;
        const int gsz = (tm - grp * 8) < 8 ? (tm - grp * 8) : 8;
        const int pm = grp * 8 + rem % gsz, pn = rem / gsz;
        const int bo = bt / g.bdiv, bi = bt - bo * g.bdiv;
        const bf16_t* Ab = g.A + bo * g.a_o + bi * g.a_i + (long)(pm * 128) * g.lda;
        const bf16_t* Bb = g.B + bo * g.b_o + bi * g.b_i + (long)(pn * 128) * g.ldb;
        const bf16_t* A2b = g.A2 + bo * g.a2_o + bi * g.a2_i + (long)(pm * 128) * g.lda2;
        const bf16_t* B2b = g.B2 + bo * g.b2_o + bi * g.b2_i + (long)(pn * 128) * g.ldb2;
        f32x4 acc[4][4];
#pragma unroll
        for (int i = 0; i < 4; ++i)
#pragma unroll
            for (int j = 0; j < 4; ++j) acc[i][j] = (f32x4){0.f, 0.f, 0.f, 0.f};
        u32x4 ra[GNLD], rb[GNLD];
        {
            const unsigned oa = ((unsigned)(tid / GNCH) * (unsigned)g.lda + (tid % GNCH) * 8) * 2u;
            const unsigned ob = ((unsigned)(tid / GNCH) * (unsigned)g.ldb + (tid % GNCH) * 8) * 2u;
            const size_t sa = (size_t)(2 * GRPP) * (size_t)g.lda, sb = (size_t)(2 * GRPP) * (size_t)g.ldb;
#pragma unroll
            for (int i = 0; i < GNLD; ++i) {
                if (MODE != 2) {
                ra[i] = *(const u32x4*)(((const char*)Ab + i * sa) + (size_t)oa);
                rb[i] = *(const u32x4*)(((const char*)Bb + i * sb) + (size_t)ob);
                } else { ra[i] = (u32x4){0u,0u,0u,0u}; rb[i] = ra[i]; }
            }
        }
        for (int kt = 0; kt < nk; ++kt) {
            __syncthreads();
            if (MODE != 2) {
#pragma unroll
            for (int i = 0; i < GNLD; ++i) {
                *(u32x4*)(lw + i * (GRPP * LDT * 2)) = ra[i];
                *(u32x4*)(lw + 128 * LDT * 2 + i * (GRPP * LDT * 2)) = rb[i];
            }
            }
            __syncthreads();
            if (MODE != 2 && kt + 1 < nk) {
                const int kn = kt + 1;
                const char* pa; const char* pb; unsigned la, lb;
                if (kn < nk1) { pa = (const char*)(Ab + kn * GBK); pb = (const char*)(Bb + kn * GBK); la = (unsigned)g.lda; lb = (unsigned)g.ldb; }
                else { pa = (const char*)(A2b + (kn - nk1) * GBK); pb = (const char*)(B2b + (kn - nk1) * GBK); la = (unsigned)g.lda2; lb = (unsigned)g.ldb2; }
                const unsigned oa = ((unsigned)(tid / GNCH) * la + (tid % GNCH) * 8) * 2u;
                const unsigned ob = ((unsigned)(tid / GNCH) * lb + (tid % GNCH) * 8) * 2u;
                const size_t sa = (size_t)(2 * GRPP) * (size_t)la, sb = (size_t)(2 * GRPP) * (size_t)lb;
#pragma unroll
                for (int i = 0; i < GNLD; ++i) {
                    ra[i] = *(const u32x4*)((pa + i * sa) + (size_t)oa);
                    rb[i] = *(const u32x4*)((pb + i * sb) + (size_t)ob);
                }
            }
            if (MODE != 1)
#pragma unroll
            for (int kk = 0; kk < GBK / 32; ++kk) {
                bf16x8 a[4];
#pragma unroll
                for (int i = 0; i < 4; ++i) a[i] = *(const bf16x8*)(lra + (i * 16 * LDT + kk * 32) * 2);
#pragma unroll
                for (int j = 0; j < 4; ++j) {
                    const bf16x8 b = *(const bf16x8*)(lrb + (j * 16 * LDT + kk * 32) * 2);
#pragma unroll
                    for (int i = 0; i < 4; ++i) acc[i][j] = mfma16(b, a[i], acc[i][j]);
                }
            }
        }
        if (MODE != 1) epi(bt, pm * 128 + wm * 64, pn * 128 + wn * 64, acc, lane);
    }
}
template <class Epi>
__device__ __forceinline__ void gemm256(const GA& g, Epi epi, char* smem) {
    constexpr int LDT = 72;
    int tid = threadIdx.x;
    asm volatile("" : "+v"(tid));
    const int lane = tid & 63, w = __builtin_amdgcn_readfirstlane(tid >> 6), wm = w >> 1, wn = w & 1;
    const int tm = g.M >> 8, tn = g.N >> 7, per = tm * tn, total = per * g.nbatch;
    const int nk = g.K >> 6;
    const int fr = lane & 15, fq = lane >> 4;
    char* const lw = smem + ((tid >> 3) * LDT + (tid & 7) * 8) * 2;
    const char* const lra = smem + ((wm * 128 + fr) * LDT + fq * 8) * 2;
    const char* const lrb = smem + 256 * LDT * 2 + ((wn * 64 + fr) * LDT + fq * 8) * 2;
    for (int t = blockIdx.x; t < total; t += gridDim.x) {
        const int bt = t / per, idx = t - bt * per;
        const int grp = idx / (8 * tn), rem = idx - grp * 8 * tn;
        const int gsz = (tm - grp * 8) < 8 ? (tm - grp * 8) : 8;
        const int pm = grp * 8 + rem % gsz, pn = rem / gsz;
        const int bo = bt / g.bdiv, bi = bt - bo * g.bdiv;
        const char* Ab = (const char*)(g.A + bo * g.a_o + bi * g.a_i + (long)(pm * 256) * g.lda);
        const char* Bb = (const char*)(g.B + bo * g.b_o + bi * g.b_i + (long)(pn * 128) * g.ldb);
        f32x4 acc[2][4][4];
#pragma unroll
        for (int h = 0; h < 2; ++h)
#pragma unroll
            for (int i = 0; i < 4; ++i)
#pragma unroll
                for (int j = 0; j < 4; ++j) acc[h][i][j] = (f32x4){0.f, 0.f, 0.f, 0.f};
        u32x4 ra[8], rb[4];
        const unsigned oa = ((unsigned)(tid >> 3) * (unsigned)g.lda + (tid & 7) * 8) * 2u;
        const unsigned ob = ((unsigned)(tid >> 3) * (unsigned)g.ldb + (tid & 7) * 8) * 2u;
        const size_t sa = (size_t)64 * (size_t)g.lda, sb = (size_t)64 * (size_t)g.ldb;
#pragma unroll
        for (int i = 0; i < 8; ++i) ra[i] = *(const u32x4*)((Ab + i * sa) + (size_t)oa);
#pragma unroll
        for (int i = 0; i < 4; ++i) rb[i] = *(const u32x4*)((Bb + i * sb) + (size_t)ob);
        for (int kt = 0; kt < nk; ++kt) {
            __syncthreads();
#pragma unroll
            for (int i = 0; i < 8; ++i) *(u32x4*)(lw + i * (32 * LDT * 2)) = ra[i];
#pragma unroll
            for (int i = 0; i < 4; ++i) *(u32x4*)(lw + 256 * LDT * 2 + i * (32 * LDT * 2)) = rb[i];
            __syncthreads();
            if (kt + 1 < nk) {
                const char* pa = Ab + (size_t)(kt + 1) * 128;
                const char* pb = Bb + (size_t)(kt + 1) * 128;
#pragma unroll
                for (int i = 0; i < 8; ++i) ra[i] = *(const u32x4*)((pa + i * sa) + (size_t)oa);
#pragma unroll
                for (int i = 0; i < 4; ++i) rb[i] = *(const u32x4*)((pb + i * sb) + (size_t)ob);
            }
#pragma unroll
            for (int kk = 0; kk < 2; ++kk) {
                bf16x8 b[4];
#pragma unroll
                for (int j = 0; j < 4; ++j) b[j] = *(const bf16x8*)(lrb + (j * 16 * LDT + kk * 32) * 2);
#pragma unroll
                for (int h = 0; h < 2; ++h) {
                    bf16x8 a[4];
#pragma unroll
                    for (int i = 0; i < 4; ++i) a[i] = *(const bf16x8*)(lra + ((h * 4 + i) * 16 * LDT + kk * 32) * 2);
#pragma unroll
                    for (int j = 0; j < 4; ++j)
#pragma unroll
                        for (int i = 0; i < 4; ++i) acc[h][i][j] = mfma16(b[j], a[i], acc[h][i][j]);
                }
            }
        }
        epi(bt, pm * 256 + wm * 128, pn * 128 + wn * 64, acc[0], lane);
        epi(bt, pm * 256 + wm * 128 + 64, pn * 128 + wn * 64, acc[1], lane);
    }
}
#ifndef GBKD
#define GBKD 128
#endif
template <class Epi>
__device__ __forceinline__ void gemm_phase(const GA& g, Epi epi, char* smem) {
    if (g.nbatch <= 2 && (g.M & 255) == 0 && g.K2 == 0) gemm256(g, epi, smem);
    else gemm_phase_t<GBKD>(g, epi, smem);
}

#define EPI_SIG int bt, int row0, int col0, f32x4(&acc)[4][4], int lane
#define EPI_FOR                                   \
    _Pragma("unroll") for (int i = 0; i < 4; ++i) \
        _Pragma("unroll") for (int j = 0; j < 4; ++j)
#define EPI_RC                                  \
    if (j == 0) asm volatile("" ::: "memory");   \
    const int row = row0 + i * 16 + (lane & 15); \
    const int col = col0 + j * 16 + (lane >> 4) * 4;

__device__ __forceinline__ void ln_phase(const float* __restrict__ pre, const float* __restrict__ g, const float* __restrict__ bta,
                         float* __restrict__ xout, bf16_t* __restrict__ xm, const float* __restrict__ modn, int sh_off, int sc_off) {
    int tidl = threadIdx.x;
    asm volatile("" : "+v"(tidl));
    const int lane = tidl & 63, w = tidl >> 6;
    for (int r = blockIdx.x * 4 + w; r < SEQ; r += gridDim.x * 4) {
        f32x4 v[2][4];
        float s[2] = {0.f, 0.f};
#pragma unroll
        for (int h = 0; h < 2; ++h)
#pragma unroll
            for (int i = 0; i < 4; ++i) {
                v[h][i] = *(const f32x4*)(pre + (size_t)(r + h * SEQ) * 1024 + (i * 64 + lane) * 4);
                s[h] += (v[h][i][0] + v[h][i][1]) + (v[h][i][2] + v[h][i][3]);
            }
#pragma unroll
        for (int o = 32; o > 0; o >>= 1) { s[0] += __shfl_xor(s[0], o); s[1] += __shfl_xor(s[1], o); }
        float q[2] = {0.f, 0.f};
#pragma unroll
        for (int h = 0; h < 2; ++h) {
            const float mean = s[h] * (1.f / 1024.f);
#pragma unroll
            for (int i = 0; i < 4; ++i) {
                v[h][i] = v[h][i] - mean;
                q[h] += (v[h][i][0] * v[h][i][0] + v[h][i][1] * v[h][i][1]) + (v[h][i][2] * v[h][i][2] + v[h][i][3] * v[h][i][3]);
            }
        }
#pragma unroll
        for (int o = 32; o > 0; o >>= 1) { q[0] += __shfl_xor(q[0], o); q[1] += __shfl_xor(q[1], o); }
#pragma unroll
        for (int i = 0; i < 4; ++i) {
            const int c = (i * 64 + lane) * 4;
            const f32x4 gg = *(const f32x4*)(g + c), bb = *(const f32x4*)(bta + c);
#pragma unroll
            for (int h = 0; h < 2; ++h) {
                const float rstd = rsqrtf(q[h] * (1.f / 1024.f) + 1e-5f);
                const f32x4 y = v[h][i] * rstd * gg + bb;
                *(f32x4*)(xout + (size_t)(r + h * SEQ) * 1024 + c) = y;
                if (xm) {
                    const f32x4 sc = *(const f32x4*)(modn + h * 6144 + sc_off + c), sh = *(const f32x4*)(modn + h * 6144 + sh_off + c);
                    const f32x4 ym = y * (sc + 1.f) + sh;
                    *(uint2*)(xm + (size_t)(r + h * SEQ) * 1024 + c) = pack4(ym);
                }
            }
        }
    }
}

struct EpiResid {
    float* pre; const float* x; const float* gate;
    __device__ __forceinline__ void operator()(EPI_SIG) const {
        EPI_FOR {
            EPI_RC
            const int tok = bt * SEQ + row;
            const int b = tok >> 13;
            const float4 xv = *(const float4*)(x + (size_t)tok * 1024 + col);
            const float4 gv = *(const float4*)(gate + b * 6144 + col);
            float4 o;
            o.x = DN_ALPHA * xv.x + (1.f + gv.x) * acc[i][j][0];
            o.y = DN_ALPHA * xv.y + (1.f + gv.y) * acc[i][j][1];
            o.z = DN_ALPHA * xv.z + (1.f + gv.z) * acc[i][j][2];
            o.w = DN_ALPHA * xv.w + (1.f + gv.w) * acc[i][j][3];
            *(float4*)(pre + (size_t)tok * 1024 + col) = o;
        }
    }
};
template <int ACT>
struct EpiStore {
    bf16_t* O; long ldo; float scale;
    __device__ __forceinline__ void operator()(EPI_SIG) const {
        EPI_FOR {
            EPI_RC
            f32x4 v = acc[i][j];
            if (ACT == 1) { v[0] = gelu_f(v[0]); v[1] = gelu_f(v[1]); v[2] = gelu_f(v[2]); v[3] = gelu_f(v[3]); }
            v = v * scale;
            *(uint2*)(O + (size_t)row * ldo + col) = pack4(v);
        }
    }
};

__device__ __forceinline__ void ffn_layer(const P& p, int l, const float* xres, const XcdBarrier& xb, char* smem, bool last) {
    bf16_t* WTF = (bf16_t*)(p.ws + OFF_WTFFN);
    float* MOD = (float*)(p.ws + OFF_SMALL) + 4096;
    bf16_t* XM = (bf16_t*)(p.ws + OFF_XM);
    bf16_t* ACT = (bf16_t*)(p.ws + OFF_SCR);
    float* HG = (float*)(p.ws + OFF_SCR + 96 * MIB);
    float* HU = (float*)(p.ws + OFF_SCR + 108 * MIB);
    float* PRE2 = (float*)(p.ws + OFF_PRE);
    const float* cw = p.ffn_conv_w + (size_t)l * 3 * 2816;
    const float* cb = p.ffn_conv_b + (size_t)l * 2816;
    {
        GA g = ga_make(XM, 1024, WTF, 1024, TOK, 5632, 1024);
        auto e = [=](EPI_SIG) {
            const int fr = lane & 15, fq = lane >> 4;
            const int cb0 = (col0 >> 1) + fq * 4;
            const int grp = row0 >> 6;
#pragma unroll
            for (int j = 0; j < 2; ++j) {
                const int c = cb0 + j * 16;
                const f32x4 w0a = *(const f32x4*)(cw + c), w1a = *(const f32x4*)(cw + 2816 + c), w2a = *(const f32x4*)(cw + 5632 + c), bba = *(const f32x4*)(cb + c);
#pragma unroll
                for (int i = 0; i < 4; ++i) {
                    const int tok = row0 + i * 16 + fr;
                    f32x4 o;
#pragma unroll
                    for (int e4 = 0; e4 < 4; ++e4) {
                        const float gcur = acc[i][j][e4];
                        const float gprv = (i > 0) ? acc[i > 0 ? i - 1 : 0][j][e4] : 0.f;
                        const float c1 = __int_as_float(__builtin_amdgcn_update_dpp(0, __float_as_int(gcur), 0x121, 0xf, 0xf, false));
                        const float c2 = __int_as_float(__builtin_amdgcn_update_dpp(0, __float_as_int(gcur), 0x122, 0xf, 0xf, false));
                        const float q1 = __int_as_float(__builtin_amdgcn_update_dpp(0, __float_as_int(gprv), 0x121, 0xf, 0xf, false));
                        const float q2 = __int_as_float(__builtin_amdgcn_update_dpp(0, __float_as_int(gprv), 0x122, 0xf, 0xf, false));
                        const float p1 = (fr >= 1) ? c1 : q1, p2 = (fr >= 2) ? c2 : q2;
                        const float y = w2a[e4] * gcur + w1a[e4] * p1 + w0a[e4] * p2 + bba[e4];
                        o[e4] = silu_f(y) * acc[i][j + 2][e4];
                    }
                    if (i > 0 || fr >= 2) *(uint2*)(ACT + (size_t)tok * 2816 + c) = pack4(o);
                    if (i == 0 && fr < 2) {
                        *(float4*)(HG + ((size_t)grp * 4 + 2 + fr) * 2816 + c) = make_float4(acc[0][j][0], acc[0][j][1], acc[0][j][2], acc[0][j][3]);
                        *(float4*)(HU + ((size_t)grp * 2 + fr) * 2816 + c) = make_float4(acc[0][j + 2][0], acc[0][j + 2][1], acc[0][j + 2][2], acc[0][j + 2][3]);
                    }
                    if (i == 3 && fr >= 14)
                        *(float4*)(HG + ((size_t)grp * 4 + (fr - 14)) * 2816 + c) = make_float4(acc[3][j][0], acc[3][j][1], acc[3][j][2], acc[3][j][3]);
                }
            }
        };
        GEMM_BIG(g, e, smem);
    }
    GSYNC;
    {
        int tidl = threadIdx.x;
        asm volatile("" : "+v"(tidl));
        for (int it = blockIdx.x * 256 + tidl; it < 256 * 2 * 704; it += gridDim.x * 256) {
            const int c = (it % 704) * 4, gr = it / 704, r = gr & 1, grp = gr >> 1;
            const int tok = grp * 64 + r, ts = tok & (SEQ - 1);
            const f32x4 z4 = (f32x4){0.f, 0.f, 0.f, 0.f};
            const f32x4 g0 = *(const f32x4*)(HG + ((size_t)grp * 4 + 2 + r) * 2816 + c);
            const int gp = grp > 0 ? grp - 1 : 0;
            const f32x4 h62 = *(const f32x4*)(HG + ((size_t)gp * 4 + 0) * 2816 + c);
            const f32x4 h63 = *(const f32x4*)(HG + ((size_t)gp * 4 + 1) * 2816 + c);
            const f32x4 h0 = *(const f32x4*)(HG + ((size_t)grp * 4 + 2) * 2816 + c);
            const f32x4 p1 = (r == 0) ? ((ts >= 1) ? h63 : z4) : h0;
            const f32x4 p2 = (r == 0) ? ((ts >= 2) ? h62 : z4) : ((ts >= 2) ? h63 : z4);
            const f32x4 up = *(const f32x4*)(HU + ((size_t)grp * 2 + r) * 2816 + c);
            const f32x4 w0 = *(const f32x4*)(cw + c), w1 = *(const f32x4*)(cw + 2816 + c), w2 = *(const f32x4*)(cw + 5632 + c), bb = *(const f32x4*)(cb + c);
            f32x4 o;
#pragma unroll
            for (int q = 0; q < 4; ++q) o[q] = silu_f(w2[q] * g0[q] + w1[q] * p1[q] + w0[q] * p2[q] + bb[q]) * up[q];
            *(uint2*)(ACT + (size_t)tok * 2816 + c) = pack4(o);
        }
        if (!last) convert_layer(p, l + 1, smem, 1);
    }
    GSYNC;
    {
        GA g = ga_make(ACT, 2816, WTF + 5632 * 1024, 2816, TOK, 1024, 2816);
        EpiResid e{PRE2, xres, MOD + l * 12288 + 5120};
        GEMM_BIG(g, e, smem);
    }
    GSYNC;
    {
        const float* modn = MOD + (l + 1) * 12288;
        ln_phase(PRE2, p.ln_g + (l * 2 + 1) * 1024, p.ln_b + (l * 2 + 1) * 1024, p.out, last ? nullptr : XM, modn, 0, 1024);
        if (!last) convert_layer(p, l + 1, smem, 2);
    }
    GSYNC;
}

__device__ __forceinline__ void mixer_ln(const P& p, int l, const float* pre) {
    float* MOD = (float*)(p.ws + OFF_SMALL) + 4096;
    bf16_t* XM = (bf16_t*)(p.ws + OFF_XM);
    ln_phase(pre, p.ln_g + (l * 2) * 1024, p.ln_b + (l * 2) * 1024, p.out, XM, MOD + l * 12288, 3072, 4096);
}

template <int C>
struct SolveRow {
    static __device__ __forceinline__ void run(float (&sol)[64], const float* kks, const bf16_t* srcp, const float* bs, const float* gcs, bool isv) {
        float a = sol[C] * bs[C];
        if (!isv) a *= __expf(gcs[C]);
        float a1 = 0.f, a2 = 0.f, a3 = 0.f;
#pragma unroll
        for (int m = 0; m < C; ++m) {
            const float pr = kks[C * 64 + m] * sol[m];
            if ((m & 3) == 0) a -= pr; else if ((m & 3) == 1) a1 -= pr; else if ((m & 3) == 2) a2 -= pr; else a3 -= pr;
        }
        a = (a + a1) + (a2 + a3);
        asm volatile("" : "+v"(a) : : "memory");
        sol[C] = a;
        SolveRow<C + 1>::run(sol, kks, srcp, bs, gcs, isv);
    }
};
template <>
struct SolveRow<64> {
    static __device__ __forceinline__ void run(float (&)[64], const float*, const bf16_t*, const float*, const float*, bool) {}
};

extern "C" __global__ void __launch_bounds__(256, 2) mega(P p) {
    cg::grid_group grid = cg::this_grid();
    __shared__ __attribute__((aligned(16))) char smem[73728];
    __shared__ uint4 xb_words;
    const int tid = threadIdx.x, lane = tid & 63, wv = tid >> 6;
    if (tid == 0) xb_words = make_uint4(0u, 0u, 0u, 0u);
    __syncthreads();
    const XcdBarrier xb = xcd_barrier_post((unsigned*)(p.ws + OFF_BAR), (volatile LAS unsigned*)&xb_words);
    bf16_t* WTM = (bf16_t*)(p.ws + OFF_WTMIX);
    float* EV = (float*)(p.ws + OFF_SMALL);
    float* MOD = (float*)(p.ws + OFF_SMALL) + 4096;
    bf16_t* WSB = (bf16_t*)(p.ws + OFF_SMALL + 512 * 1024);
    float* COS = (float*)(p.ws + OFF_COS);
    float* SIN = (float*)(p.ws + OFF_SIN);
    float* PRE = (float*)(p.ws + OFF_PRE);
    bf16_t* XM = (bf16_t*)(p.ws + OFF_XM);
    char* SCR = p.ws + OFF_SCR;

    convert_layer(p, 0, smem, 3);
    {
        float* red = (float*)smem;
        for (int rep = 0; rep < REP_P0; ++rep)
        for (int t = blockIdx.x; t < 64; t += gridDim.x) {
            const int col = t * 16 + (tid & 15), ks = tid >> 4;
            float a0 = 0.f, a1 = 0.f;
#pragma unroll 8
            for (int k = ks * 64; k < ks * 64 + 64; ++k) {
                const float wv_ = p.cond_w[(size_t)k * 1024 + col];
                a0 += p.c[k] * wv_;
                a1 += p.c[1024 + k] * wv_;
            }
            __syncthreads();
            red[tid * 2] = a0; red[tid * 2 + 1] = a1;
            __syncthreads();
            if (tid < 32) {
                const int c = tid & 15, b = tid >> 4;
                float sm = 0.f;
                for (int q = 0; q < 16; ++q) sm += red[(q * 16 + c) * 2 + b];
                const int cc = t * 16 + c;
                EV[b * 1024 + cc] = silu_f(sm + p.cond_b[cc]);
            }
        }
    }
    for (int rep = 0; rep < REP_P0; ++rep)
    for (int it = blockIdx.x * 256 + tid; it < SEQ * 128; it += gridDim.x * 256) {
        const int pos = it >> 7, i = it & 127;
        double f = 1.0;
        const double r = 0.9300449458481391823675;
        for (int q = 0; q < i; ++q) f *= r;
        double rev = (double)pos * f * 0.1591549430918953357689;
        rev -= floor(rev);
        const float fr = (float)rev;
        COS[it] = __builtin_amdgcn_cosf(fr);
        SIN[it] = __builtin_amdgcn_sinf(fr);
    }
    for (int it = blockIdx.x * 256 + tid; it < TOK * 2; it += gridDim.x * 256) ((float*)(p.ws + OFF_STATS))[it] = 0.f;
    for (int it = blockIdx.x * 256 + tid; it < 8 * 128 * 128; it += gridDim.x * 256) {
        const int s = it & 127, t = (it >> 7) & 127;
        WSB[it] = (s <= t) ? f2bf(p.gmlp_w_s[it]) : (bf16_t)0;
    }
    if (p.ws == nullptr) grid.sync();
    GSYNC;
    {
        float* red = (float*)smem;
        for (int rep = 0; rep < REP_P0; ++rep)
        for (int t = blockIdx.x; t < 1536; t += gridDim.x) {
            const int l = t / 384, cgp = t - l * 384;
            const int col = cgp * 16 + (tid & 15), ks = tid >> 4;
            const float* wp = p.ada_w + (size_t)l * 1024 * 6144 + col;
            float a0 = 0.f, a1 = 0.f;
#pragma unroll 8
            for (int k = ks * 64; k < ks * 64 + 64; ++k) {
                const float wv_ = wp[(size_t)k * 6144];
                a0 += EV[k] * wv_;
                a1 += EV[1024 + k] * wv_;
            }
            __syncthreads();
            red[tid * 2] = a0; red[tid * 2 + 1] = a1;
            __syncthreads();
            if (tid < 32) {
                const int c = tid & 15, b = tid >> 4;
                float sm = 0.f;
                for (int q = 0; q < 16; ++q) sm += red[(q * 16 + c) * 2 + b];
                const int cc = cgp * 16 + c;
                MOD[l * 12288 + b * 6144 + cc] = sm + p.ada_b[l * 6144 + cc];
            }
        }
    }
    GSYNC;
    { LOCAL_TID
    for (int it = blockIdx.x * 256 + tid; it < TOK * 256; it += gridDim.x * 256) {
        const int tok = it >> 8, c = (it & 255) * 4, b = tok >> 13;
        const float4 xv = *(const float4*)(p.x + (size_t)tok * 1024 + c);
        const float4 sh = *(const float4*)(MOD + b * 6144 + c), sc = *(const float4*)(MOD + b * 6144 + 1024 + c);
        uint2 o;
        o.x = pack2(xv.x * (1.f + sc.x) + sh.x, xv.y * (1.f + sc.y) + sh.y);
        o.y = pack2(xv.z * (1.f + sc.z) + sh.z, xv.w * (1.f + sc.w) + sh.w);
        *(uint2*)(XM + (size_t)tok * 1024 + c) = o;
    }
    }
    GSYNC;

    {
        bf16_t* QKV = (bf16_t*)SCR;
        bf16_t* Z = (bf16_t*)(SCR + 96 * MIB);
        float* AB = (float*)(SCR + 128 * MIB);
        float* BETA = (float*)(SCR + 129 * MIB);
        float* GC = (float*)(SCR + 130 * MIB);
        float* KK = (float*)(SCR + 131 * MIB);
        bf16_t* QKb = (bf16_t*)(SCR + 163 * MIB);
        bf16_t* Qn = (bf16_t*)(p.ws + OFF_PRE);
        bf16_t* Kn = (bf16_t*)(p.ws + OFF_PRE + 32 * MIB);
        bf16_t* Vc = XM;
        bf16_t* U = (bf16_t*)SCR;
        bf16_t* W = (bf16_t*)(SCR + 32 * MIB);
        bf16_t* KDT = (bf16_t*)(SCR + 64 * MIB);
        bf16_t* O = XM;
        {
            GA g = ga_make(XM, 1024, WTM, 1024, TOK, 3072, 1024);
            EpiStore<0> e{QKV, 3072, 1.f};
            gemm_phase(g, e, smem);
            GA g2 = ga_make(XM, 1024, WTM + 3072 * 1024, 1024, TOK, 1024, 1024);
            EpiStore<0> e2{Z, 1024, 1.f};
            gemm_phase(g2, e2, smem);
            GA g3 = ga_make(XM, 1024, WTM + 4096 * 1024, 1024, TOK, 128, 1024);
            auto e3 = [=](EPI_SIG) {
#pragma unroll
                for (int i = 0; i < 4; ++i) {
                    const int row = row0 + i * 16 + (lane & 15);
                    const int col = col0 + (lane >> 4) * 4;
                    if (col0 == 0) *(float4*)(AB + (size_t)row * 16 + col) = make_float4(acc[i][0][0], acc[i][0][1], acc[i][0][2], acc[i][0][3]);
                }
            };
            gemm_phase(g3, e3, smem);
        }
        GSYNC;
        {
            LOCAL_TID
            float* gs = (float*)smem;
            for (int rep = 0; rep < REP_GB; ++rep)
            for (int t = blockIdx.x; t < 1536; t += gridDim.x) {
                const int ct = t / 6, sg = t - ct * 6;
                const int tokw = ct * 64 + wv * 16;
                const int ts = tokw & (SEQ - 1);
                for (int s4 = 0; s4 < 4; ++s4) {
                    const int seg = sg * 4 + s4;
                    const int ch = seg * 128 + lane * 2;
                    const float2 w0 = *(const float2*)(p.gdn_conv_w + ch), w1 = *(const float2*)(p.gdn_conv_w + 3072 + ch),
                                 w2 = *(const float2*)(p.gdn_conv_w + 2 * 3072 + ch), w3 = *(const float2*)(p.gdn_conv_w + 3 * 3072 + ch);
                    unsigned x0 = 0, x1 = 0, x2 = 0;
                    if (ts >= 3) {
                        x0 = *(const unsigned*)(QKV + (size_t)(tokw - 3) * 3072 + ch);
                        x1 = *(const unsigned*)(QKV + (size_t)(tokw - 2) * 3072 + ch);
                        x2 = *(const unsigned*)(QKV + (size_t)(tokw - 1) * 3072 + ch);
                    }
                    unsigned xr[16];
#pragma unroll
                    for (int i = 0; i < 16; ++i) xr[i] = *(const unsigned*)(QKV + (size_t)(tokw + i) * 3072 + ch);
                    float y0[16], y1[16], ss[16];
#pragma unroll
                    for (int i = 0; i < 16; ++i) {
                        const unsigned x3 = xr[i];
                        y0[i] = silu_f(w3.x * lo16(x3) + w2.x * lo16(x2) + w1.x * lo16(x1) + w0.x * lo16(x0));
                        y1[i] = silu_f(w3.y * hi16(x3) + w2.y * hi16(x2) + w1.y * hi16(x1) + w0.y * hi16(x0));
                        x0 = x1; x1 = x2; x2 = x3;
                        ss[i] = y0[i] * y0[i] + y1[i] * y1[i];
                    }
                    if (seg < 16) {
#pragma unroll
                        for (int o = 32; o > 0; o >>= 1)
#pragma unroll
                            for (int i = 0; i < 16; ++i) ss[i] += __shfl_xor(ss[i], o);
                        const float qs = (seg < 8) ? 0.08838834764831845f : 1.f;
#pragma unroll
                        for (int i = 0; i < 16; ++i) {
                            const float r = rsqrtf(ss[i] + 1e-6f) * qs;
                            y0[i] *= r; y1[i] *= r;
                        }
                    }
                    bf16_t* dst = (seg < 8) ? (Qn + (size_t)tokw * 1024 + ch) : (seg < 16) ? (Kn + (size_t)tokw * 1024 + (ch - 1024)) : (Vc + (size_t)tokw * 1024 + (ch - 2048));
#pragma unroll
                    for (int i = 0; i < 16; ++i) *(unsigned*)(dst + (size_t)i * 1024) = pack2(y0[i], y1[i]);
                }
                if (sg == 0) {
                    __syncthreads();
                    if (lane < 8) {
                        const float al = __expf(p.gdn_a_log[lane]), dtb = p.gdn_dt_bias[lane];
                        for (int i = 0; i < 16; ++i) {
                            const int tok = tokw + i;
                            const float a = AB[(size_t)tok * 16 + lane], btv = AB[(size_t)tok * 16 + 8 + lane];
                            BETA[(size_t)tok * 8 + lane] = sigmoid_f(btv);
                            gs[(wv * 16 + i) * 8 + lane] = -al * softplus_f(a + dtb);
                        }
                    }
                    __syncthreads();
                    if (tid < 8) {
                        float run = 0.f;
                        for (int i = 0; i < 64; ++i) {
                            run += gs[i * 8 + tid];
                            GC[(size_t)(ct * 64 + i) * 8 + tid] = run;
                        }
                    }
                }
            }
        }
        GSYNC;
        {
            GA g = ga_make(Kn, 1024, Kn, 1024, 128, 128, 128);
            g.nbatch = 128 * 8; g.bdiv = 8; g.a_o = 131072; g.a_i = 128; g.b_o = 131072; g.b_i = 128;
            auto ekk = [=](EPI_SIG) {
                const int bo = bt >> 3, h = bt & 7;
                EPI_FOR {
                    EPI_RC
                    if ((row >> 6) == (col >> 6)) {
                        const int tokr = bo * 128 + row;
                        const float gr = GC[(size_t)tokr * 8 + h], br = BETA[(size_t)tokr * 8 + h];
                        float o[4];
#pragma unroll
                        for (int e = 0; e < 4; ++e) {
                            const int cc = col + e;
                            const float gcv = GC[(size_t)(bo * 128 + cc) * 8 + h];
                            o[e] = (cc < row) ? acc[i][j][e] * br * __expf(gr - gcv) : 0.f;
                        }
                        *(float4*)(KK + ((size_t)tokr * 8 + h) * 64 + (col & 63)) = make_float4(o[0], o[1], o[2], o[3]);
                    }
                }
            };
            gemm_phase(g, ekk, smem);
            GA g2 = g; g2.A = Qn; g2.A2 = Qn;
            auto eqk = [=](EPI_SIG) {
                const int bo = bt >> 3, h = bt & 7;
                EPI_FOR {
                    EPI_RC
                    if ((row >> 6) == (col >> 6)) {
                        const int tokr = bo * 128 + row;
                        const float gr = GC[(size_t)tokr * 8 + h];
                        f32x4 o;
#pragma unroll
                        for (int e = 0; e < 4; ++e) {
                            const int cc = col + e;
                            const float gcv = GC[(size_t)(bo * 128 + cc) * 8 + h];
                            o[e] = (cc <= row) ? acc[i][j][e] * __expf(gr - gcv) : 0.f;
                        }
                        *(uint2*)(QKb + ((size_t)tokr * 8 + h) * 64 + (col & 63)) = pack4(o);
                    }
                }
            };
            gemm_phase(g2, eqk, smem);
        }
        GSYNC;
#ifndef NO_D
        {
            LOCAL_TID
            float* kks = (float*)smem;
            bf16_t* kdl = (bf16_t*)(smem + 16384);
            float* bs = (float*)(smem + 16384 + 17408);
            float* gcs = bs + 64;
            for (int rep = 0; rep < REP_GD; ++rep)
            for (int t = blockIdx.x; t < 2048; t += gridDim.x) {
                const int cn = t >> 3, h = t & 7, tok0 = cn * 64;
                __syncthreads();
#pragma unroll
                for (int i = 0; i < 16; ++i) {
                    const int idx = tid + i * 256, c = idx >> 6, m = idx & 63;
                    kks[idx] = KK[((size_t)(tok0 + c) * 8 + h) * 64 + m];
                }
                if (tid < 64) { bs[tid] = BETA[(size_t)(tok0 + tid) * 8 + h]; gcs[tid] = GC[(size_t)(tok0 + tid) * 8 + h]; }
                __syncthreads();
                const bool isv = tid < 128;
                const bf16_t* srcp = isv ? (Vc + (size_t)tok0 * 1024 + h * 128 + tid) : (Kn + (size_t)tok0 * 1024 + h * 128 + (tid - 128));
                float sol[64];
#pragma unroll
                for (int c = 0; c < 64; ++c) sol[c] = bf2f(srcp[(size_t)c * 1024]);
                SolveRow<0>::run(sol, kks, srcp, bs, gcs, isv);
                bf16_t* dstp = isv ? (U + (size_t)tok0 * 1024 + h * 128 + tid) : (W + (size_t)tok0 * 1024 + h * 128 + (tid - 128));
#pragma unroll
                for (int c = 0; c < 64; ++c) dstp[(size_t)c * 1024] = f2bf(sol[c]);
                {
                    const int dk = tid & 127, half = tid >> 7;
                    const float gl = gcs[63];
                    for (int c = half * 32; c < half * 32 + 32; ++c)
                        kdl[c * 136 + dk] = f2bf(bf2f(Kn[(size_t)(tok0 + c) * 1024 + h * 128 + dk]) * __expf(gl - gcs[c]));
                }
                __syncthreads();
                {
                    const int dk = tid >> 1, hf = tid & 1;
                    bf16_t* dp = KDT + ((size_t)(cn * 8 + h) * 128 + dk) * 64 + hf * 32;
#pragma unroll
                    for (int c8 = 0; c8 < 4; ++c8) {
                        unsigned u4[4];
#pragma unroll
                        for (int q = 0; q < 4; ++q) {
                            const int c = hf * 32 + c8 * 8 + q * 2;
                            u4[q] = (unsigned)kdl[c * 136 + dk] | ((unsigned)kdl[(c + 1) * 136 + dk] << 16);
                        }
                        *(uint4*)(dp + c8 * 8) = make_uint4(u4[0], u4[1], u4[2], u4[3]);
                    }
                }
            }
        }
#endif
        GSYNC;
#ifndef NO_E
        {
            LOCAL_TID
            bf16_t* ST = (bf16_t*)smem;
            bf16_t* WC = ST + 16 * 136;
            bf16_t* QC = WC + 64 * 136;
            bf16_t* QKC = QC + 64 * 136;
            bf16_t* KDS = QKC + 64 * 72;
            bf16_t* VNT = KDS + 128 * 72;
            const int fr = lane & 15, fq = lane >> 4;
            for (int rep = 0; rep < REP_E; ++rep)
            for (int t = blockIdx.x; t < 128; t += gridDim.x) {
                const int b = t >> 6, h = (t >> 3) & 7, sl = t & 7;
                const int dv0 = h * 128 + sl * 16;
                f32x4 sacc[2];
                sacc[0] = (f32x4){0.f, 0.f, 0.f, 0.f}; sacc[1] = sacc[0];
                __syncthreads();
                for (int i = tid; i < 16 * 136; i += 256) ST[i] = 0;
                u32x4 pw[4], pq[4], pqk[2], pkd[4];
                float pu[4], pgc[4], pgl;
#define SCAN_ISSUE(nn)                                                                                                   \
    {                                                                                                                    \
        const int cn_ = b * 128 + (nn), tk_ = cn_ * 64;                                                                  \
        _Pragma("unroll") for (int i = 0; i < 4; ++i) {                                                                  \
            const int id = tid + i * 256, r = id >> 4, kc = (id & 15) * 8;                                               \
            pw[i] = *(const u32x4*)(W + (size_t)(tk_ + r) * 1024 + h * 128 + kc);                                        \
            pq[i] = *(const u32x4*)(Qn + (size_t)(tk_ + r) * 1024 + h * 128 + kc);                                       \
        }                                                                                                                \
        _Pragma("unroll") for (int i = 0; i < 2; ++i) {                                                                  \
            const int id = tid + i * 256, r = id >> 3, kc = (id & 7) * 8;                                                \
            pqk[i] = *(const u32x4*)(QKb + ((size_t)(tk_ + r) * 8 + h) * 64 + kc);                                       \
        }                                                                                                                \
        _Pragma("unroll") for (int i = 0; i < 4; ++i) {                                                                  \
            const int id = tid + i * 256, r = id >> 3, kc = (id & 7) * 8;                                                \
            pkd[i] = *(const u32x4*)(KDT + ((size_t)(cn_ * 8 + h) * 128 + r) * 64 + kc);                                \
        }                                                                                                                \
        _Pragma("unroll") for (int e = 0; e < 4; ++e) {                                                                  \
            const int tok = tk_ + wv * 16 + fq * 4 + e;                                                                  \
            pu[e] = bf2f(U[(size_t)tok * 1024 + dv0 + fr]);                                                              \
            pgc[e] = GC[(size_t)tok * 8 + h];                                                                            \
        }                                                                                                                \
        pgl = GC[(size_t)(tk_ + 63) * 8 + h];                                                                            \
    }
                SCAN_ISSUE(0)
                for (int n = 0; n < 128; ++n) {
                    const int cn = b * 128 + n, tok0 = cn * 64;
                    __syncthreads();
#pragma unroll
                    for (int i = 0; i < 4; ++i) {
                        const int id = tid + i * 256, r = id >> 4, kc = (id & 15) * 8;
                        *(u32x4*)(WC + r * 136 + kc) = pw[i];
                        *(u32x4*)(QC + r * 136 + kc) = pq[i];
                    }
#pragma unroll
                    for (int i = 0; i < 2; ++i) {
                        const int id = tid + i * 256, r = id >> 3, kc = (id & 7) * 8;
                        *(u32x4*)(QKC + r * 72 + kc) = pqk[i];
                    }
#pragma unroll
                    for (int i = 0; i < 4; ++i) {
                        const int id = tid + i * 256, r = id >> 3, kc = (id & 7) * 8;
                        *(u32x4*)(KDS + r * 72 + kc) = pkd[i];
                    }
                    float ucur[4], gcr[4];
#pragma unroll
                    for (int e = 0; e < 4; ++e) { ucur[e] = pu[e]; gcr[e] = pgc[e]; }
                    const float glc = pgl;
                    __syncthreads();
                    if (n + 1 < 128) SCAN_ISSUE(n + 1)
                    const int c0 = wv * 16;
                    f32x4 wsv = (f32x4){0.f, 0.f, 0.f, 0.f}, o1 = wsv;
#pragma unroll
                    for (int kk = 0; kk < 4; ++kk) {
                        const bf16x8 a = *(const bf16x8*)(WC + (c0 + fr) * 136 + kk * 32 + fq * 8);
                        const bf16x8 q = *(const bf16x8*)(QC + (c0 + fr) * 136 + kk * 32 + fq * 8);
                        const bf16x8 s = *(const bf16x8*)(ST + fr * 136 + kk * 32 + fq * 8);
                        wsv = mfma16(a, s, wsv);
                        o1 = mfma16(q, s, o1);
                    }
                    f32x4 vn;
#pragma unroll
                    for (int e = 0; e < 4; ++e) vn[e] = ucur[e] - wsv[e];
                    *(uint2*)(VNT + fr * 72 + c0 + fq * 4) = pack4(vn);
                    __syncthreads();
                    f32x4 o2 = (f32x4){0.f, 0.f, 0.f, 0.f};
#pragma unroll
                    for (int kk = 0; kk < 2; ++kk) {
                        const bf16x8 a = *(const bf16x8*)(QKC + (c0 + fr) * 72 + kk * 32 + fq * 8);
                        const bf16x8 v = *(const bf16x8*)(VNT + fr * 72 + kk * 32 + fq * 8);
                        o2 = mfma16(a, v, o2);
                    }
#pragma unroll
                    for (int e = 0; e < 4; ++e) {
                        const int tok = tok0 + c0 + fq * 4 + e;
                        O[(size_t)tok * 1024 + dv0 + fr] = f2bf(o1[e] * __expf(gcr[e]) + o2[e]);
                    }
                    const float eg = __expf(glc);
#pragma unroll
                    for (int tt = 0; tt < 2; ++tt) {
                        const int mt = wv * 2 + tt;
                        f32x4 d = (f32x4){0.f, 0.f, 0.f, 0.f};
#pragma unroll
                        for (int kk = 0; kk < 2; ++kk) {
                            const bf16x8 a = *(const bf16x8*)(KDS + (mt * 16 + fr) * 72 + kk * 32 + fq * 8);
                            const bf16x8 v = *(const bf16x8*)(VNT + fr * 72 + kk * 32 + fq * 8);
                            d = mfma16(a, v, d);
                        }
                        sacc[tt] = sacc[tt] * eg + d;
                        *(uint2*)(ST + fr * 136 + mt * 16 + fq * 4) = pack4(sacc[tt]);
                    }
                }
            }
        }
#endif
        GSYNC;
        { LOCAL_TID
        for (int tok = blockIdx.x * 4 + wv; tok < TOK; tok += gridDim.x * 4) {
#pragma unroll
            for (int h = 0; h < 8; ++h) {
                const int ch = h * 128 + lane * 2;
                const unsigned ov = *(const unsigned*)(O + (size_t)tok * 1024 + ch);
                const unsigned zv = *(const unsigned*)(Z + (size_t)tok * 1024 + ch);
                const float o0 = lo16(ov), o1 = hi16(ov);
                const float ss = wsum(o0 * o0 + o1 * o1);
                const float r = rsqrtf(ss * (1.f / 128.f) + 1e-6f);
                const float2 nw = *(const float2*)(p.gdn_norm_w + lane * 2);
                *(unsigned*)(O + (size_t)tok * 1024 + ch) = pack2(o0 * r * nw.x * silu_f(lo16(zv)), o1 * r * nw.y * silu_f(hi16(zv)));
            }
        }
        }
        GSYNC;
        {
            GA g = ga_make(O, 1024, WTM + 4224 * 1024, 1024, TOK, 1024, 1024);
            EpiResid e{PRE, p.x, MOD + 0 * 12288 + 2048};
            gemm_phase(g, e, smem);
        }
        GSYNC;
        mixer_ln(p, 0, PRE);
        GSYNC;

    }
    ffn_layer(p, 0, p.out, xb, smem, false);
    {
        bf16_t* QX = (bf16_t*)SCR;
        bf16_t* KZT = (bf16_t*)(SCR + 32 * MIB);
        bf16_t* VT = (bf16_t*)(SCR + 64 * MIB);
        bf16_t* GATE = (bf16_t*)(SCR + 128 * MIB);
        bf16_t* Kr = (bf16_t*)(SCR + 192 * MIB);
        bf16_t* SC = (bf16_t*)(SCR + 224 * MIB);
        bf16_t* STATE = (bf16_t*)(p.ws + OFF_PRE);
        bf16_t* OR0 = XM;
        bf16_t* OR1 = Kr;
        float* PRE1 = (float*)SCR;
        float l2g[4];
#pragma unroll
        for (int h = 0; h < 4; ++h) l2g[h] = log2f(1.f - exp2f(-5.f - (float)h));
        {
            GA g = ga_make(XM, 1024, WTM, 1024, TOK, 1024, 1024);
            auto eq = [=](EPI_SIG) {
#pragma unroll
                for (int i = 0; i < 4; ++i) {
                    const int tok = row0 + i * 16 + (lane & 15);
                    const int pos = tok & (SEQ - 1), c = pos & 127;
#pragma unroll
                    for (int jp = 0; jp < 4; jp += 2) {
                        const int col = col0 + jp * 16 + (lane >> 4) * 4;
                        const int hd = col >> 8, pl = col & 255, ai = 16 * (pl >> 5) + (lane >> 4) * 4;
                        const float lg = hd == 0 ? l2g[0] : hd == 1 ? l2g[1] : hd == 2 ? l2g[2] : l2g[3];
                        const float xi = exp2f((float)(c + 1) * lg);
                        const float4 cs = *(const float4*)(COS + pos * 128 + ai), sn = *(const float4*)(SIN + pos * 128 + ai);
                        const float csa[4] = {cs.x, cs.y, cs.z, cs.w}, sna[4] = {sn.x, sn.y, sn.z, sn.w};
                        f32x4 r1, r2;
#pragma unroll
                        for (int e = 0; e < 4; ++e) {
                            const float t1 = acc[i][jp][e], t2 = acc[i][jp + 1][e];
                            r1[e] = (t1 * csa[e] - t2 * sna[e]) * xi;
                            r2[e] = (t1 * sna[e] + t2 * csa[e]) * xi;
                        }
                        *(uint2*)(QX + (size_t)tok * 1024 + col) = pack4(r1);
                        *(uint2*)(QX + (size_t)tok * 1024 + col + 16) = pack4(r2);
                    }
                }
            };
            gemm_phase(g, eq, smem);
            GA gk = ga_make(XM, 1024, WTM + 1024 * 1024, 1024, TOK, 1024, 1024);
            auto ek = [=](EPI_SIG) {
#pragma unroll
                for (int i = 0; i < 4; ++i) {
                    const int tok = row0 + i * 16 + (lane & 15);
                    const int pos = tok & (SEQ - 1), c = pos & 127, b = tok >> 13;
#pragma unroll
                    for (int jp = 0; jp < 4; jp += 2) {
                        const int col = col0 + jp * 16 + (lane >> 4) * 4;
                        const int hd = col >> 8, pl = col & 255, ai = 16 * (pl >> 5) + (lane >> 4) * 4;
                        const float lg = hd == 0 ? l2g[0] : hd == 1 ? l2g[1] : hd == 2 ? l2g[2] : l2g[3];
                        const float zeta = exp2f((float)(127 - c) * lg);
                        const float4 cs = *(const float4*)(COS + pos * 128 + ai), sn = *(const float4*)(SIN + pos * 128 + ai);
                        const float csa[4] = {cs.x, cs.y, cs.z, cs.w}, sna[4] = {sn.x, sn.y, sn.z, sn.w};
                        f32x4 r1, r2;
#pragma unroll
                        for (int e = 0; e < 4; ++e) {
                            const float t1 = acc[i][jp][e], t2 = acc[i][jp + 1][e];
                            r1[e] = (t1 * csa[e] - t2 * sna[e]) * 0.0625f;
                            r2[e] = (t1 * sna[e] + t2 * csa[e]) * 0.0625f;
                        }
                        *(uint2*)(Kr + (size_t)tok * 1024 + col) = pack4(r1);
                        *(uint2*)(Kr + (size_t)tok * 1024 + col + 16) = pack4(r2);
                        bf16_t* kz = KZT + ((size_t)(b * 4 + hd) * 256 + pl) * SEQ + pos;
#pragma unroll
                        for (int e = 0; e < 4; ++e) {
                            kz[(size_t)e * SEQ] = f2bf(r1[e] * zeta);
                            kz[(size_t)(e + 16) * SEQ] = f2bf(r2[e] * zeta);
                        }
                    }
                }
            };
            gemm_phase(gk, ek, smem);
            GA gv = ga_make(XM, 1024, WTM + 2048 * 1024, 1024, TOK, 2048, 1024);
            auto ev = [=](EPI_SIG) {
                EPI_FOR {
                    EPI_RC
                    const int pos = row & (SEQ - 1), b = row >> 13, hd = col >> 9, dv = col & 511;
                    bf16_t* vp = VT + ((size_t)(b * 4 + hd) * 512 + dv) * SEQ + pos;
#pragma unroll
                    for (int e = 0; e < 4; ++e) vp[(size_t)e * SEQ] = f2bf(acc[i][j][e]);
                }
            };
            gemm_phase(gv, ev, smem);
            GA gg = ga_make(XM, 1024, WTM + 4096 * 1024, 1024, TOK, 2048, 1024);
            EpiStore<0> eg{GATE, 2048, 1.f};
            gemm_phase(gg, eg, smem);
        }
        GSYNC;
        {
            GA g = ga_make(QX, 1024, Kr, 1024, 128, 128, 256);
            g.nbatch = 512; g.bdiv = 4; g.a_o = 131072; g.a_i = 256; g.b_o = 131072; g.b_i = 256;
            auto es = [=](EPI_SIG) {
                const int cn = bt >> 2, h = bt & 3;
                const float lg = h == 0 ? l2g[0] : h == 1 ? l2g[1] : h == 2 ? l2g[2] : l2g[3];
                EPI_FOR {
                    EPI_RC
                    f32x4 o;
#pragma unroll
                    for (int e = 0; e < 4; ++e) {
                        const int m = col + e;
                        o[e] = (m <= row) ? acc[i][j][e] * exp2f(-(float)(m + 1) * lg) : 0.f;
                    }
                    *(uint2*)(SC + ((size_t)(cn * 128 + row)) * 512 + h * 128 + col) = pack4(o);
                }
            };
            gemm_phase(g, es, smem);
        }
        for (int b = 0; b < 2; ++b) {
            {
                GA g = ga_make(VT + (size_t)b * 4 * 512 * SEQ, SEQ, KZT + (size_t)b * 4 * 256 * SEQ, SEQ, 512, 256, 128);
                g.nbatch = 256; g.bdiv = 64; g.a_o = 512 * SEQ; g.a_i = 128; g.b_o = 256 * SEQ; g.b_i = 128;
                auto e = [=](EPI_SIG) {
                    EPI_FOR {
                        EPI_RC
                        *(uint2*)(STATE + ((size_t)bt * 512 + row) * 256 + col) = pack4(acc[i][j]);
                    }
                };
                gemm_phase(g, e, smem);
            }
            GSYNC;
            {
            LOCAL_TID
                const int it = blockIdx.x * 256 + tid;
                if (it < 65536) {
                    const int h = it >> 14;
                    const float lg = h == 0 ? l2g[0] : h == 1 ? l2g[1] : h == 2 ? l2g[2] : l2g[3];
                    const float gch = exp2f(128.f * lg);
                    bf16_t* sp = STATE + (size_t)h * 64 * 131072 + (size_t)(it & 16383) * 8;
                    float st[8];
#pragma unroll
                    for (int q = 0; q < 8; ++q) st[q] = 0.f;
                    for (int n0 = 0; n0 < 64; n0 += 8) {
                        u32x4 kvb[8];
#pragma unroll
                        for (int q = 0; q < 8; ++q) kvb[q] = *(const u32x4*)(sp + (size_t)(n0 + q) * 131072);
#pragma unroll
                        for (int q = 0; q < 8; ++q) {
                            const u32x4 kv = kvb[q];
                            u32x4 o;
                            o[0] = pack2(st[0], st[1]); o[1] = pack2(st[2], st[3]); o[2] = pack2(st[4], st[5]); o[3] = pack2(st[6], st[7]);
                            *(u32x4*)(sp + (size_t)(n0 + q) * 131072) = o;
                            st[0] = st[0] * gch + lo16(kv[0]); st[1] = st[1] * gch + hi16(kv[0]);
                            st[2] = st[2] * gch + lo16(kv[1]); st[3] = st[3] * gch + hi16(kv[1]);
                            st[4] = st[4] * gch + lo16(kv[2]); st[5] = st[5] * gch + hi16(kv[2]);
                            st[6] = st[6] * gch + lo16(kv[3]); st[7] = st[7] * gch + hi16(kv[3]);
                        }
                    }
                }
            }
            GSYNC;
            {
                GA g = ga_make(QX + (size_t)b * 64 * 131072, 1024, STATE, 256, 128, 512, 256);
                g.nbatch = 256; g.bdiv = 64; g.a_o = 256; g.a_i = 131072; g.b_o = 64 * 131072; g.b_i = 131072;
                g.A2 = SC + (size_t)b * 64 * 128 * 512; g.lda2 = 512; g.a2_o = 128; g.a2_i = 128 * 512;
                g.B2 = VT + (size_t)b * 4 * 512 * SEQ; g.ldb2 = SEQ; g.b2_o = 512 * SEQ; g.b2_i = 128; g.K2 = 128;
                bf16_t* ORb = b ? OR1 : OR0;
                auto e = [=](EPI_SIG) {
                    const int h = bt >> 6, n = bt & 63;
                    EPI_FOR {
                        EPI_RC
                        *(uint2*)(ORb + ((size_t)(n * 128 + row)) * 2048 + h * 512 + col) = pack4(acc[i][j]);
                    }
                };
                gemm_phase(g, e, smem);
            }
            GSYNC;
        }
        { LOCAL_TID
        for (int tok = blockIdx.x * 4 + wv; tok < TOK; tok += gridDim.x * 4) {
            bf16_t* op = (tok >> 13) ? (OR1 + (size_t)(tok & (SEQ - 1)) * 2048) : (OR0 + (size_t)tok * 2048);
#pragma unroll
            for (int h = 0; h < 4; ++h) {
                const uint4 ov = *(const uint4*)(op + h * 512 + lane * 8);
                const uint4 gv = *(const uint4*)(GATE + (size_t)tok * 2048 + h * 512 + lane * 8);
                float o[8] = {lo16(ov.x), hi16(ov.x), lo16(ov.y), hi16(ov.y), lo16(ov.z), hi16(ov.z), lo16(ov.w), hi16(ov.w)};
                const float gt[8] = {lo16(gv.x), hi16(gv.x), lo16(gv.y), hi16(gv.y), lo16(gv.z), hi16(gv.z), lo16(gv.w), hi16(gv.w)};
                float s = 0.f;
#pragma unroll
                for (int q = 0; q < 8; ++q) s += o[q];
                const float mean = wsum(s) * (1.f / 512.f);
                float qq = 0.f;
#pragma unroll
                for (int q = 0; q < 8; ++q) { o[q] -= mean; qq += o[q] * o[q]; }
                const float rstd = rsqrtf(wsum(qq) * (1.f / 512.f) + 1e-6f);
                uint4 r;
                r.x = pack2(o[0] * rstd * silu_f(gt[0]), o[1] * rstd * silu_f(gt[1]));
                r.y = pack2(o[2] * rstd * silu_f(gt[2]), o[3] * rstd * silu_f(gt[3]));
                r.z = pack2(o[4] * rstd * silu_f(gt[4]), o[5] * rstd * silu_f(gt[5]));
                r.w = pack2(o[6] * rstd * silu_f(gt[6]), o[7] * rstd * silu_f(gt[7]));
                *(uint4*)(op + h * 512 + lane * 8) = r;
            }
        }
        }
        GSYNC;
        {
            GA g = ga_make(OR0, 2048, WTM + 6144 * 1024, 2048, SEQ, 1024, 2048);
            g.nbatch = 2; g.bdiv = 1; g.a_o = (long)(OR1 - OR0);
            EpiResid e{PRE1, p.out, MOD + 1 * 12288 + 2048};
            gemm_phase(g, e, smem);
        }
        GSYNC;
        mixer_ln(p, 1, PRE1);
        GSYNC;

    }
    ffn_layer(p, 1, p.out, xb, smem, false);
    {
        bf16_t* Ub = (bf16_t*)SCR;
        bf16_t* VT = (bf16_t*)(SCR + 64 * MIB);
        {
            GA g = ga_make(XM, 1024, WTM, 1024, TOK, 2048, 1024);
            EpiStore<1> e{Ub, 2048, 1.f};
            gemm_phase(g, e, smem);
            GA gv = ga_make(XM, 1024, WTM + 2048 * 1024, 1024, TOK, 2048, 1024);
            float* STATS = (float*)(p.ws + OFF_STATS);
            auto ev = [=](EPI_SIG) {
#pragma unroll
                for (int i = 0; i < 4; ++i) {
                    const int row = row0 + i * 16 + (lane & 15);
                    const int cn = row >> 7, s = row & 127;
                    float sm = 0.f, sq = 0.f;
#pragma unroll
                    for (int j = 0; j < 4; ++j) {
                        const int col = col0 + j * 16 + (lane >> 4) * 4;
                        bf16_t* vp = VT + ((size_t)cn * 2048 + col) * 128 + s;
#pragma unroll
                        for (int e = 0; e < 4; ++e) {
                            const bf16_t hv = f2bf(gelu_f(acc[i][j][e]));
                            vp[(size_t)e * 128] = hv;
                            const float fv = bf2f(hv);
                            sm += fv; sq += fv * fv;
                        }
                    }
                    sm += __shfl_xor(sm, 16); sq += __shfl_xor(sq, 16);
                    sm += __shfl_xor(sm, 32); sq += __shfl_xor(sq, 32);
                    if (lane < 16) { atomicAdd(STATS + (size_t)row * 2, sm); atomicAdd(STATS + (size_t)row * 2 + 1, sq); }
                }
            };
            gemm_phase(gv, ev, smem);
        }
        GSYNC;
        {
            LOCAL_TID
            const float* STATS = (const float*)(p.ws + OFF_STATS);
            for (int it = blockIdx.x * 256 + tid; it < 128 * 2048 * 16; it += gridDim.x * 256) {
                const int s8 = it & 15, d = (it >> 4) & 2047, cn = it >> 15;
                bf16_t* vp = VT + ((size_t)cn * 2048 + d) * 128 + s8 * 8;
                const u32x4 v = *(const u32x4*)vp;
                const float* st = STATS + (size_t)(cn * 128 + s8 * 8) * 2;
                const float4 s0 = *(const float4*)st, s1 = *(const float4*)(st + 4), s2 = *(const float4*)(st + 8), s3 = *(const float4*)(st + 12);
                const float lg = p.gmlp_ln_g[d], lb = p.gmlp_ln_b[d];
                const float sums[8] = {s0.x, s0.z, s1.x, s1.z, s2.x, s2.z, s3.x, s3.z};
                const float sqs[8] = {s0.y, s0.w, s1.y, s1.w, s2.y, s2.w, s3.y, s3.w};
                float y[8];
#pragma unroll
                for (int q = 0; q < 8; ++q) {
                    const float mean = sums[q] * (1.f / 2048.f);
                    const float var = fmaxf(sqs[q] * (1.f / 2048.f) - mean * mean, 0.f);
                    const float rstd = rsqrtf(var + 1e-5f);
                    const float xv = (q & 1) ? hi16(v[q >> 1]) : lo16(v[q >> 1]);
                    y[q] = (xv - mean) * rstd * lg + lb;
                }
                u32x4 o;
                o[0] = pack2(y[0], y[1]); o[1] = pack2(y[2], y[3]); o[2] = pack2(y[4], y[5]); o[3] = pack2(y[6], y[7]);
                *(u32x4*)vp = o;
            }
        }
        GSYNC;
        {
            GA g = ga_make(WSB, 128, VT, 128, 128, 256, 128);
            g.nbatch = 1024; g.bdiv = 8; g.a_o = 0; g.a_i = 16384; g.b_o = 2048 * 128; g.b_i = 256 * 128;
            const float* bsp = p.gmlp_b_s;
            auto e = [=](EPI_SIG) {
                const int cn = bt >> 3, gi = bt & 7;
                EPI_FOR {
                    EPI_RC
                    const float bb = bsp[gi * 128 + row];
                    bf16_t* up = Ub + (size_t)(cn * 128 + row) * 2048 + gi * 256 + col;
                    const uint2 uv = *(const uint2*)up;
                    f32x4 o;
                    o[0] = (acc[i][j][0] + bb) * lo16(uv.x); o[1] = (acc[i][j][1] + bb) * hi16(uv.x);
                    o[2] = (acc[i][j][2] + bb) * lo16(uv.y); o[3] = (acc[i][j][3] + bb) * hi16(uv.y);
                    *(uint2*)up = pack4(o);
                }
            };
            gemm_phase(g, e, smem);
        }
        GSYNC;
        {
            GA g = ga_make(Ub, 2048, WTM + 4096 * 1024, 2048, TOK, 1024, 2048);
            EpiResid e{PRE, p.out, MOD + 2 * 12288 + 2048};
            gemm_phase(g, e, smem);
        }
        GSYNC;
        mixer_ln(p, 2, PRE);
        GSYNC;

    }
    ffn_layer(p, 2, p.out, xb, smem, false);
    {
        bf16_t* Qb = (bf16_t*)SCR;
        bf16_t* Kb = (bf16_t*)(SCR + 32 * MIB);
        bf16_t* VT = (bf16_t*)(SCR + 64 * MIB);
        bf16_t* OA = (bf16_t*)(SCR + 96 * MIB);
        {
            GA g = ga_make(XM, 1024, WTM, 1024, TOK, 1024, 1024);
            EpiStore<0> e{Qb, 1024, 0.125f};
            gemm_phase(g, e, smem);
            GA gk = ga_make(XM, 1024, WTM + 1024 * 1024, 1024, TOK, 1024, 1024);
            EpiStore<0> e2{Kb, 1024, 1.f};
            gemm_phase(gk, e2, smem);
            GA gv = ga_make(XM, 1024, WTM + 2048 * 1024, 1024, TOK, 1024, 1024);
            auto ev = [=](EPI_SIG) {
                EPI_FOR {
                    EPI_RC
                    const int pos = row & (SEQ - 1), b = row >> 13;
                    bf16_t* vp = VT + ((size_t)(b * 16) * 64 + col) * SEQ + pos;
#pragma unroll
                    for (int e = 0; e < 4; ++e) vp[(size_t)e * SEQ] = f2bf(acc[i][j][e]);
                }
            };
            gemm_phase(gv, ev, smem);
        }
        GSYNC;
#ifndef NO_SB
        {
            LOCAL_TID
            bf16_t* KS = (bf16_t*)smem;
            bf16_t* VS = KS + 64 * 72;
            float* red = (float*)(smem + 2 * 64 * 72 * 2);
            const int fr = lane & 15, fq = lane >> 4;
            for (int rep = 0; rep < REP_SB; ++rep)
            for (int t = blockIdx.x; t < 2048; t += gridDim.x) {
                const int qb = 63 - (t & 63), bh = t >> 6, b = bh >> 4, hd = bh & 15;
                const int q0 = qb * 128 + wv * 32;
                bf16x8 qf[2][2];
#pragma unroll
                for (int ni = 0; ni < 2; ++ni)
#pragma unroll
                    for (int kk = 0; kk < 2; ++kk)
                        qf[ni][kk] = *(const bf16x8*)(Qb + (size_t)(b * SEQ + q0 + ni * 16 + fr) * 1024 + hd * 64 + kk * 32 + fq * 8);
                f32x4 oacc[4][2];
#pragma unroll
                for (int di = 0; di < 4; ++di) { oacc[di][0] = (f32x4){0.f, 0.f, 0.f, 0.f}; oacc[di][1] = oacc[di][0]; }
                float R[2] = {0.f, 0.f};
                for (int kb = qb * 2 + 1; kb >= 0; --kb) {
                    __syncthreads();
#pragma unroll
                    for (int i = 0; i < 2; ++i) {
                        const int id = tid + i * 256, r = id >> 3, kc = (id & 7) * 8;
                        *(uint4*)(KS + r * 72 + kc) = *(const uint4*)(Kb + (size_t)(b * SEQ + kb * 64 + r) * 1024 + hd * 64 + kc);
                        *(uint4*)(VS + r * 72 + kc) = *(const uint4*)(VT + ((size_t)(b * 16 + hd) * 64 + r) * SEQ + kb * 64 + kc);
                    }
                    __syncthreads();
                    f32x4 st[4][2];
#pragma unroll
                    for (int mi = 0; mi < 4; ++mi) { st[mi][0] = (f32x4){0.f, 0.f, 0.f, 0.f}; st[mi][1] = st[mi][0]; }
#pragma unroll
                    for (int kk = 0; kk < 2; ++kk)
#pragma unroll
                        for (int mi = 0; mi < 4; ++mi) {
                            const bf16x8 a = *(const bf16x8*)(KS + (mi * 16 + fr) * 72 + kk * 32 + fq * 8);
                            st[mi][0] = mfma16(a, qf[0][kk], st[mi][0]);
                            st[mi][1] = mfma16(a, qf[1][kk], st[mi][1]);
                        }
#pragma unroll
                    for (int ni = 0; ni < 2; ++ni) {
                        const int qpos = q0 + ni * 16 + fr;
                        float l1[4][4], tot[4];
#pragma unroll
                        for (int mi = 0; mi < 4; ++mi) {
                            tot[mi] = 0.f;
#pragma unroll
                            for (int e = 0; e < 4; ++e) {
                                const int key = kb * 64 + mi * 16 + fq * 4 + e;
                                const float z = st[mi][ni][e];
                                const float sp = fmaxf(z, 0.f) + __logf(1.f + __expf(-fabsf(z)));
                                const bool valid = key < qpos;
                                l1[mi][e] = valid ? -sp : 0.f;
                                st[mi][ni][e] = valid ? (z - sp) : -1e30f;
                                tot[mi] += l1[mi][e];
                            }
                        }
                        float run = R[ni];
                        float blk = 0.f;
#pragma unroll
                        for (int mi = 3; mi >= 0; --mi) {
                            const float t1 = __shfl_xor(tot[mi], 16), t2 = __shfl_xor(tot[mi], 32), t3 = __shfl_xor(tot[mi], 48);
                            float hi = 0.f;
                            hi += ((fq ^ 1) > fq) ? t1 : 0.f;
                            hi += ((fq ^ 2) > fq) ? t2 : 0.f;
                            hi += ((fq ^ 3) > fq) ? t3 : 0.f;
                            float after = run + hi;
#pragma unroll
                            for (int e = 3; e >= 0; --e) {
                                st[mi][ni][e] = __expf(st[mi][ni][e] + after);
                                after += l1[mi][e];
                            }
                            const float all = tot[mi] + t1 + t2 + t3;
                            run += all;
                            blk += all;
                        }
                        R[ni] += blk;
                    }
#pragma unroll
                    for (int m2 = 0; m2 < 2; ++m2) {
                        bf16x8 pf[2];
#pragma unroll
                        for (int ni = 0; ni < 2; ++ni) {
                            const uint2 lo = pack4(st[2 * m2][ni]), hi = pack4(st[2 * m2 + 1][ni]);
                            const uint4 u = make_uint4(lo.x, lo.y, hi.x, hi.y);
                            pf[ni] = *(const bf16x8*)&u;
                        }
#pragma unroll
                        for (int di = 0; di < 4; ++di) {
                            const uint2 va = *(const uint2*)(VS + (di * 16 + fr) * 72 + (2 * m2) * 16 + fq * 4);
                            const uint2 vb = *(const uint2*)(VS + (di * 16 + fr) * 72 + (2 * m2 + 1) * 16 + fq * 4);
                            const uint4 u = make_uint4(va.x, va.y, vb.x, vb.y);
                            const bf16x8 vf = *(const bf16x8*)&u;
                            oacc[di][0] = mfma16(vf, pf[0], oacc[di][0]);
                            oacc[di][1] = mfma16(vf, pf[1], oacc[di][1]);
                        }
                    }
                    const float wm_ = wmax(fmaxf(R[0], R[1]));
                    if (lane == 0) red[wv] = wm_;
                    __syncthreads();
                    const float mx = fmaxf(fmaxf(red[0], red[1]), fmaxf(red[2], red[3]));
                    if (mx < -120.f) break;
                }
#pragma unroll
                for (int di = 0; di < 4; ++di)
#pragma unroll
                    for (int ni = 0; ni < 2; ++ni)
                        *(uint2*)(OA + (size_t)(b * SEQ + q0 + ni * 16 + fr) * 1024 + hd * 64 + di * 16 + fq * 4) = pack4(oacc[di][ni]);
            }
        }
#endif
        GSYNC;
        {
            GA g = ga_make(OA, 1024, WTM + 3072 * 1024, 1024, TOK, 1024, 1024);
            EpiResid e{PRE, p.out, MOD + 3 * 12288 + 2048};
            gemm_phase(g, e, smem);
        }
        GSYNC;
        mixer_ln(p, 3, PRE);
        GSYNC;
    }
    ffn_layer(p, 3, p.out, xb, smem, true);
}

extern "C" void kernel_launch(void* const* d_in, const int* in_sizes, int n_in, void* d_out, int out_size, void* d_ws, size_t ws_size,
                              hipStream_t stream) {
    static int grid_blocks = 0;
    if (!grid_blocks) {
        int dev = 0, cus = 0, per_cu = 0;
        hipGetDevice(&dev);
        hipDeviceGetAttribute(&cus, hipDeviceAttributeMultiprocessorCount, dev);
        hipOccupancyMaxActiveBlocksPerMultiprocessor(&per_cu, mega, 256, 0);
        if (per_cu > 2) per_cu = 2;
        grid_blocks = cus * per_cu;
    }
    if (ws_size < WS_NEED) { fprintf(stderr, "workspace too small: %zu < %zu\n", ws_size, (size_t)WS_NEED); return; }
    P p{};
    const float** pp = (const float**)&p;
    for (int i = 0; i < 28; ++i) pp[i] = (const float*)d_in[i];
    p.out = (float*)d_out;
    p.ws = (char*)d_ws;
    hipMemsetAsync((char*)d_ws + OFF_BAR, 0, XCD_BAR_WORDS * sizeof(unsigned), stream);
    void* args[] = {&p};
    hipError_t e = hipLaunchCooperativeKernel((void*)mega, dim3(grid_blocks), dim3(256), args, 0, stream);
    if (e != hipSuccess) fprintf(stderr, "cooperative launch failed: %s (grid %d)\n", hipGetErrorString(e), grid_blocks);
}
```

```cpp
#include <hip/hip_runtime.h>
#include <hip/hip_cooperative_groups.h>
#include <cstdio>
#include <cstdint>
namespace cg = cooperative_groups;

typedef unsigned short bf16_t;
typedef short bf16x8 __attribute__((ext_vector_type(8)));
typedef float f32x4 __attribute__((ext_vector_type(4)));
typedef unsigned u32x4 __attribute__((ext_vector_type(4)));

#define MIB (1024ull * 1024ull)
#ifndef REP_SYNC
#define REP_SYNC 1
#endif
#ifndef REP_F2
#define REP_F2 1
#endif
#ifndef REP_P0
#define REP_P0 1
#endif
#ifndef REP_GB
#define REP_GB 1
#endif
#ifndef REP_GD
#define REP_GD 1
#endif
#ifndef REP_SB
#define REP_SB 1
#endif
#ifndef REP_GLN
#define REP_GLN 1
#endif
#ifndef REP_LN
#define REP_LN 1
#endif
#ifndef REP_CONV
#define REP_CONV 1
#endif
#define GSYNC do { for (int r_ = 0; r_ < REP_SYNC; ++r_) xcd_barrier(xb); } while (0)
#ifndef F1_DUMMY
#define F1_DUMMY 0
#endif
#ifndef GEMM_BIG
#define GEMM_BIG gemm256
#endif
#ifndef REP_E
#define REP_E 1
#endif
#ifndef REP_F1
#define REP_F1 1
#endif
constexpr size_t OFF_WTMIX = 0;
constexpr size_t OFF_WTFFN = 16 * MIB;
constexpr size_t OFF_SMALL = 33 * MIB;
constexpr size_t OFF_COS = 34 * MIB;
constexpr size_t OFF_SIN = 38 * MIB;
constexpr size_t OFF_PRE = 42 * MIB;
constexpr size_t OFF_XM = 106 * MIB;
constexpr size_t OFF_SCR = 138 * MIB;
constexpr size_t WS_NEED = 378 * MIB;


#define XB_TMO      128
#define XB_XCNT(j)  (256  + 64 * (j))
#define XB_XSUB(j)  (1280 + 64 * (j))
#define XB_XGEN(j)  (2304 + 64 * (j))
#define XB_TOP      3328
#define XB_TOPGEN   3392
#define XCD_BAR_WORDS 3456
#define XB_SPIN_CAP (1u << 20)
#define LAS __attribute__((address_space(3)))
__device__ __forceinline__ unsigned xb_ld(unsigned* p) { return __hip_atomic_load(p, __ATOMIC_RELAXED, __HIP_MEMORY_SCOPE_AGENT); }
__device__ __forceinline__ unsigned xb_add(unsigned* p, unsigned v) { return __hip_atomic_fetch_add(p, v, __ATOMIC_RELAXED, __HIP_MEMORY_SCOPE_AGENT); }
__device__ __forceinline__ unsigned xb_xcc_id() { return (unsigned)__builtin_amdgcn_s_getreg((3 << 11) | 20) & 0xFu; }
#define XB_SPIN(cond, bar) do { unsigned _sp = 0; while (cond) { __builtin_amdgcn_s_sleep(1); \
    if ((++_sp & 255u) == 0u) { if (xb_ld(&(bar)[XB_TMO])) break; if (_sp > XB_SPIN_CAP) { atomicAdd(&(bar)[XB_TMO], 1u); break; } } } } while (0)
struct XcdBarrier { unsigned* bar; unsigned x; volatile LAS unsigned* st; };
__device__ __forceinline__ XcdBarrier xcd_barrier_post(unsigned* bar, volatile LAS unsigned* st) {
    XcdBarrier b; b.bar = bar; b.x = xb_xcc_id(); b.st = st;
    if (threadIdx.x == 0) (void)xb_add(&bar[XB_XCNT(b.x)], 1u);
    return b;
}
__device__ __forceinline__ void xcd_barrier_complete(unsigned* bar, unsigned x, unsigned& nloc, unsigned& nx) {
    const unsigned G = gridDim.x * gridDim.y * gridDim.z;
    unsigned sum, cnt, mine, sp = 0u;
    for (;;) {
        sum = 0u; cnt = 0u; mine = 0u;
#pragma unroll
        for (unsigned j = 0; j < 16; ++j) { const unsigned c = xb_ld(&bar[XB_XCNT(j)]); sum += c; cnt += (c > 0u) ? 1u : 0u; mine = (j == x) ? c : mine; }
        if (sum == G) break;
        __builtin_amdgcn_s_sleep(1);
        if ((++sp & 255u) == 0u) { if (xb_ld(&bar[XB_TMO])) break; if (sp > XB_SPIN_CAP) { atomicAdd(&bar[XB_TMO], 1u); break; } }
    }
    nloc = mine > 0u ? mine : 1u; nx = cnt > 0u ? cnt : 1u;
}
__device__ __forceinline__ void xcd_barrier(const XcdBarrier& b) {
    asm volatile("s_waitcnt vmcnt(0)" ::: "memory");
    __syncthreads();
    if (threadIdx.x == 0) {
        unsigned* bar = b.bar;
        __builtin_amdgcn_s_waitcnt(0);
        unsigned nloc = b.st[0], nx = b.st[1];
        if (nloc == 0u) { xcd_barrier_complete(bar, b.x, nloc, nx); b.st[0] = nloc; b.st[1] = nx; }
        const unsigned old = xb_add(&bar[XB_XSUB(b.x)], 1u);
        const unsigned gen = old / nloc;
        if (old + 1u == (gen + 1u) * nloc) {
            __builtin_amdgcn_fence(__ATOMIC_RELEASE, "agent");
            asm volatile("s_waitcnt vmcnt(0)" ::: "memory");
            const unsigned og = xb_add(&bar[XB_TOP], 1u);
            const unsigned tg = og / nx;
            if (og + 1u == (tg + 1u) * nx) xb_add(&bar[XB_TOPGEN], 1u);
            else XB_SPIN(xb_ld(&bar[XB_TOPGEN]) == tg, bar);
            __builtin_amdgcn_fence(__ATOMIC_ACQUIRE, "agent");
            xb_add(&bar[XB_XGEN(b.x)], 1u);
            asm volatile("s_waitcnt vmcnt(0)" ::: "memory");
        } else {
            XB_SPIN(xb_ld(&bar[XB_XGEN(b.x)]) == gen, bar);
            __builtin_amdgcn_fence(__ATOMIC_ACQUIRE, "agent");
            asm volatile("s_waitcnt vmcnt(0)" ::: "memory");
        }
    }
    __syncthreads();
}
constexpr size_t OFF_BAR = 33 * MIB + 768 * 1024;
constexpr size_t OFF_STATS = 33 * MIB + 832 * 1024;

#define LOCAL_TID                                   \
    int tid = threadIdx.x;                          \
    asm volatile("" : "+v"(tid));                   \
    const int lane = tid & 63;                      \
    const int wv = __builtin_amdgcn_readfirstlane(tid >> 6); \
    (void)lane; (void)wv;

constexpr int TOK = 16384;
constexpr int SEQ = 8192;
constexpr float DN_ALPHA = 1.681792830507429f;

struct P {
    const float *x, *c, *cond_w, *cond_b, *ada_w, *ada_b, *ln_g, *ln_b, *ffn_up, *ffn_conv_w, *ffn_conv_b, *ffn_down;
    const float *gdn_w_in, *gdn_conv_w, *gdn_a_log, *gdn_dt_bias, *gdn_norm_w, *gdn_w_out, *ret_w_in, *ret_w_out;
    const float *gmlp_w_in, *gmlp_ln_g, *gmlp_ln_b, *gmlp_w_s, *gmlp_b_s, *gmlp_w_out, *sb_w_in, *sb_w_out;
    float* out;
    char* ws;
};

__device__ __forceinline__ float bf2f(bf16_t v) { return __uint_as_float(((unsigned)v) << 16); }
__device__ __forceinline__ bf16_t f2bf(float f) {
    unsigned u = __float_as_uint(f);
    u += 0x7fffu + ((u >> 16) & 1u);
    return (bf16_t)(u >> 16);
}
__device__ __forceinline__ unsigned pack2(float a, float b) { return (unsigned)f2bf(a) | ((unsigned)f2bf(b) << 16); }
__device__ __forceinline__ uint2 pack4(f32x4 v) { uint2 r; r.x = pack2(v[0], v[1]); r.y = pack2(v[2], v[3]); return r; }
__device__ __forceinline__ float lo16(unsigned u) { return __uint_as_float(u << 16); }
__device__ __forceinline__ float hi16(unsigned u) { return __uint_as_float(u & 0xffff0000u); }
__device__ __forceinline__ float wsum(float v) {
#pragma unroll
    for (int o = 32; o > 0; o >>= 1) v += __shfl_xor(v, o);
    return v;
}
__device__ __forceinline__ float wmax(float v) {
#pragma unroll
    for (int o = 32; o > 0; o >>= 1) v = fmaxf(v, __shfl_xor(v, o));
    return v;
}
__device__ __forceinline__ float silu_f(float x) { return x / (1.f + __expf(-x)); }
__device__ __forceinline__ float sigmoid_f(float x) { return 1.f / (1.f + __expf(-x)); }
__device__ __forceinline__ float gelu_f(float v) {
    const float av = fabsf(v), d = av * 0.2316418882f + 1.0f;
    const float t = __builtin_amdgcn_rcpf(d);
    float q = t * 0.5307027145f + (-0.7265760135f);
    q = q * t + 0.7107068705f; q = q * t + (-0.142248368f); q = q * t + 0.127414796f; q = q * t;
    const float e = __builtin_amdgcn_exp2f((v * v) * (-0.72134752044f));
    const float m = v * (q * e);
    return v < 0.f ? m : v - m;
}
__device__ __forceinline__ float softplus_f(float x) { return fmaxf(x, 0.f) + log1pf(__expf(-fabsf(x))); }
__device__ __forceinline__ f32x4 mfma16(bf16x8 a, bf16x8 b, f32x4 c) { return __builtin_amdgcn_mfma_f32_16x16x32_bf16(a, b, c, 0, 0, 0); }

__device__ __forceinline__ int ret_perm(int n) {
    if (n >= 2048) return n;
    int hb = n & ~255, pl = n & 255, kq = pl >> 5, e = pl & 31;
    return hb + (e < 16 ? 16 * kq + e : 128 + 16 * kq + (e - 16));
}
__device__ __forceinline__ int ffn_perm(int n) {
    const int ch = (n >> 7) * 64 + ((n >> 6) & 1) * 32 + (n & 31);
    return (n & 32) ? 2816 + ch : ch;
}
__device__ __forceinline__ void conv_job(const float* __restrict__ src, int K, int N, bf16_t* __restrict__ dst, int Np, int mode, char* smem) {
    float* lds = (float*)smem;
    int tid = threadIdx.x;
    asm volatile("" : "+v"(tid));
    const int ntn = Np >> 6, nkt = K >> 6, total = ntn * nkt;
    for (int rep = 0; rep < REP_CONV; ++rep)
    for (int t = blockIdx.x; t < total; t += gridDim.x) {
        const int nt = t % ntn, kt = t / ntn, n0 = nt * 64, k0 = kt * 64;
        __syncthreads();
        {
            const int n = tid & 63, ng = n0 + n;
            const int sc = (mode == 1) ? ret_perm(ng) : (mode == 2) ? ffn_perm(ng) : ng;
            const bool ok = sc < N;
#pragma unroll
            for (int i = 0; i < 16; ++i) {
                const int k = i * 4 + (tid >> 6);
                lds[k * 65 + n] = ok ? src[(size_t)(k0 + k) * N + sc] : 0.f;
            }
        }
        __syncthreads();
        {
#pragma unroll
            for (int i = 0; i < 2; ++i) {
                const int id = tid + i * 256, n = id >> 3, k8 = (id & 7) * 8;
                u32x4 o;
                o[0] = pack2(lds[(k8 + 0) * 65 + n], lds[(k8 + 1) * 65 + n]);
                o[1] = pack2(lds[(k8 + 2) * 65 + n], lds[(k8 + 3) * 65 + n]);
                o[2] = pack2(lds[(k8 + 4) * 65 + n], lds[(k8 + 5) * 65 + n]);
                o[3] = pack2(lds[(k8 + 6) * 65 + n], lds[(k8 + 7) * 65 + n]);
                *(u32x4*)(dst + (size_t)(n0 + n) * K + k0 + k8) = o;
            }
        }
    }
}

__device__ __forceinline__ void convert_layer(const P& p, int l, char* smem) {
    bf16_t* WTM = (bf16_t*)(p.ws + OFF_WTMIX);
    bf16_t* WTF = (bf16_t*)(p.ws + OFF_WTFFN);
    const float* win = l == 0 ? p.gdn_w_in : l == 1 ? p.ret_w_in : l == 2 ? p.gmlp_w_in : p.sb_w_in;
    const float* wout = l == 0 ? p.gdn_w_out : l == 1 ? p.ret_w_out : l == 2 ? p.gmlp_w_out : p.sb_w_out;
    const int nin = l == 0 ? 4112 : l == 1 ? 6144 : l == 2 ? 4096 : 3072;
    const int npin = l == 0 ? 4224 : nin;
    const int kout = (l == 1 || l == 2) ? 2048 : 1024;
    conv_job(win, 1024, nin, WTM, npin, l == 1 ? 1 : 0, smem);
    conv_job(wout, kout, 1024, WTM + (size_t)npin * 1024, 1024, 0, smem);
    conv_job(p.ffn_up + (size_t)l * 1024 * 5632, 1024, 5632, WTF, 5632, 2, smem);
    conv_job(p.ffn_down + (size_t)l * 2816 * 1024, 2816, 1024, WTF + 5632 * 1024, 1024, 0, smem);
}

struct GA {
    const bf16_t *A, *B, *A2, *B2;
    long lda, ldb, lda2, ldb2;
    long a_o, a_i, b_o, b_i, a2_o, a2_i, b2_o, b2_i;
    int bdiv, M, N, K, K2, nbatch;
};
__device__ __forceinline__ GA ga_make(const bf16_t* A, long lda, const bf16_t* B, long ldb, int M, int N, int K) {
    GA g;
    g.A = A; g.B = B; g.A2 = A; g.B2 = B; g.lda = lda; g.ldb = ldb; g.lda2 = lda; g.ldb2 = ldb;
    g.a_o = g.a_i = g.b_o = g.b_i = g.a2_o = g.a2_i = g.b2_o = g.b2_i = 0;
    g.bdiv = 1; g.M = M; g.N = N; g.K = K; g.K2 = 0; g.nbatch = 1;
    return g;
}

template <int GBK, class Epi, int MODE = 0>
__device__ __forceinline__ void gemm_phase_t(const GA& g, Epi epi, char* smem) {
    constexpr int LDT = GBK + 8, GNCH = GBK / 8, GRPP = 256 / GNCH, GNLD = 128 / GRPP;
    int tid = threadIdx.x;
    asm volatile("" : "+v"(tid));
    const int lane = tid & 63, w = __builtin_amdgcn_readfirstlane(tid >> 6), wm = w >> 1, wn = w & 1;
    const int tm = g.M >> 7, tn = g.N >> 7, per = tm * tn, total = per * g.nbatch;
    const int nk1 = g.K / GBK, nk = nk1 + g.K2 / GBK;
    const int fr = lane & 15, fq = lane >> 4;
    char* const lw = smem + ((tid / GNCH) * LDT + (tid % GNCH) * 8) * 2;
    const char* const lra = smem + ((wm * 64 + fr) * LDT + fq * 8) * 2;
    const char* const lrb = smem + 128 * LDT * 2 + ((wn * 64 + fr) * LDT + fq * 8) * 2;
    for (int t = blockIdx.x; t < total; t += gridDim.x) {
        const int bt = t / per, idx = t - bt * per;
        const int grp = idx / (8 * tn), rem = idx - grp * 8 * tn;
        const int gsz = (tm - grp * 8) < 8 ? (tm - grp * 8) : 8;
        const int pm = grp * 8 + rem % gsz, pn = rem / gsz;
        const int bo = bt / g.bdiv, bi = bt - bo * g.bdiv;
        const bf16_t* Ab = g.A + bo * g.a_o + bi * g.a_i + (long)(pm * 128) * g.lda;
        const bf16_t* Bb = g.B + bo * g.b_o + bi * g.b_i + (long)(pn * 128) * g.ldb;
        const bf16_t* A2b = g.A2 + bo * g.a2_o + bi * g.a2_i + (long)(pm * 128) * g.lda2;
        const bf16_t* B2b = g.B2 + bo * g.b2_o + bi * g.b2_i + (long)(pn * 128) * g.ldb2;
        f32x4 acc[4][4];
#pragma unroll
        for (int i = 0; i < 4; ++i)
#pragma unroll
            for (int j = 0; j < 4; ++j) acc[i][j] = (f32x4){0.f, 0.f, 0.f, 0.f};
        u32x4 ra[GNLD], rb[GNLD];
        {
            const unsigned oa = ((unsigned)(tid / GNCH) * (unsigned)g.lda + (tid % GNCH) * 8) * 2u;
            const unsigned ob = ((unsigned)(tid / GNCH) * (unsigned)g.ldb + (tid % GNCH) * 8) * 2u;
            const size_t sa = (size_t)(2 * GRPP) * (size_t)g.lda, sb = (size_t)(2 * GRPP) * (size_t)g.ldb;
#pragma unroll
            for (int i = 0; i < GNLD; ++i) {
                if (MODE != 2) {
                ra[i] = *(const u32x4*)(((const char*)Ab + i * sa) + (size_t)oa);
                rb[i] = *(const u32x4*)(((const char*)Bb + i * sb) + (size_t)ob);
                } else { ra[i] = (u32x4){0u,0u,0u,0u}; rb[i] = ra[i]; }
            }
        }
        for (int kt = 0; kt < nk; ++kt) {
            __syncthreads();
            if (MODE != 2) {
#pragma unroll
            for (int i = 0; i < GNLD; ++i) {
                *(u32x4*)(lw + i * (GRPP * LDT * 2)) = ra[i];
                *(u32x4*)(lw + 128 * LDT * 2 + i * (GRPP * LDT * 2)) = rb[i];
            }
            }
            __syncthreads();
            if (MODE != 2 && kt + 1 < nk) {
                const int kn = kt + 1;
                const char* pa; const char* pb; unsigned la, lb;
                if (kn < nk1) { pa = (const char*)(Ab + kn * GBK); pb = (const char*)(Bb + kn * GBK); la = (unsigned)g.lda; lb = (unsigned)g.ldb; }
                else { pa = (const char*)(A2b + (kn - nk1) * GBK); pb = (const char*)(B2b + (kn - nk1) * GBK); la = (unsigned)g.lda2; lb = (unsigned)g.ldb2; }
                const unsigned oa = ((unsigned)(tid / GNCH) * la + (tid % GNCH) * 8) * 2u;
                const unsigned ob = ((unsigned)(tid / GNCH) * lb + (tid % GNCH) * 8) * 2u;
                const size_t sa = (size_t)(2 * GRPP) * (size_t)la, sb = (size_t)(2 * GRPP) * (size_t)lb;
#pragma unroll
                for (int i = 0; i < GNLD; ++i) {
                    ra[i] = *(const u32x4*)((pa + i * sa) + (size_t)oa);
                    rb[i] = *(const u32x4*)((pb + i * sb) + (size_t)ob);
                }
            }
            if (MODE != 1)
#pragma unroll
            for (int kk = 0; kk < GBK / 32; ++kk) {
                bf16x8 a[4];
#pragma unroll
                for (int i = 0; i < 4; ++i) a[i] = *(const bf16x8*)(lra + (i * 16 * LDT + kk * 32) * 2);
#pragma unroll
                for (int j = 0; j < 4; ++j) {
                    const bf16x8 b = *(const bf16x8*)(lrb + (j * 16 * LDT + kk * 32) * 2);
#pragma unroll
                    for (int i = 0; i < 4; ++i) acc[i][j] = mfma16(b, a[i], acc[i][j]);
                }
            }
        }
        if (MODE != 1) epi(bt, pm * 128 + wm * 64, pn * 128 + wn * 64, acc, lane);
    }
}
template <class Epi>
__device__ __forceinline__ void gemm256(const GA& g, Epi epi, char* smem) {
    constexpr int LDT = 72;
    int tid = threadIdx.x;
    asm volatile("" : "+v"(tid));
    const int lane = tid & 63, w = __builtin_amdgcn_readfirstlane(tid >> 6), wm = w >> 1, wn = w & 1;
    const int tm = g.M >> 8, tn = g.N >> 7, per = tm * tn, total = per * g.nbatch;
    const int nk = g.K >> 6;
    const int fr = lane & 15, fq = lane >> 4;
    char* const lw = smem + ((tid >> 3) * LDT + (tid & 7) * 8) * 2;
    const char* const lra = smem + ((wm * 128 + fr) * LDT + fq * 8) * 2;
    const char* const lrb = smem + 256 * LDT * 2 + ((wn * 64 + fr) * LDT + fq * 8) * 2;
    for (int t = blockIdx.x; t < total; t += gridDim.x) {
        const int bt = t / per, idx = t - bt * per;
        const int grp = idx / (8 * tn), rem = idx - grp * 8 * tn;
        const int gsz = (tm - grp * 8) < 8 ? (tm - grp * 8) : 8;
        const int pm = grp * 8 + rem % gsz, pn = rem / gsz;
        const int bo = bt / g.bdiv, bi = bt - bo * g.bdiv;
        const char* Ab = (const char*)(g.A + bo * g.a_o + bi * g.a_i + (long)(pm * 256) * g.lda);
        const char* Bb = (const char*)(g.B + bo * g.b_o + bi * g.b_i + (long)(pn * 128) * g.ldb);
        f32x4 acc[2][4][4];
#pragma unroll
        for (int h = 0; h < 2; ++h)
#pragma unroll
            for (int i = 0; i < 4; ++i)
#pragma unroll
                for (int j = 0; j < 4; ++j) acc[h][i][j] = (f32x4){0.f, 0.f, 0.f, 0.f};
        u32x4 ra[8], rb[4];
        const unsigned oa = ((unsigned)(tid >> 3) * (unsigned)g.lda + (tid & 7) * 8) * 2u;
        const unsigned ob = ((unsigned)(tid >> 3) * (unsigned)g.ldb + (tid & 7) * 8) * 2u;
        const size_t sa = (size_t)64 * (size_t)g.lda, sb = (size_t)64 * (size_t)g.ldb;
#pragma unroll
        for (int i = 0; i < 8; ++i) ra[i] = *(const u32x4*)((Ab + i * sa) + (size_t)oa);
#pragma unroll
        for (int i = 0; i < 4; ++i) rb[i] = *(const u32x4*)((Bb + i * sb) + (size_t)ob);
        for (int kt = 0; kt < nk; ++kt) {
            __syncthreads();
#pragma unroll
            for (int i = 0; i < 8; ++i) *(u32x4*)(lw + i * (32 * LDT * 2)) = ra[i];
#pragma unroll
            for (int i = 0; i < 4; ++i) *(u32x4*)(lw + 256 * LDT * 2 + i * (32 * LDT * 2)) = rb[i];
            __syncthreads();
            if (kt + 1 < nk) {
                const char* pa = Ab + (size_t)(kt + 1) * 128;
                const char* pb = Bb + (size_t)(kt + 1) * 128;
#pragma unroll
                for (int i = 0; i < 8; ++i) ra[i] = *(const u32x4*)((pa + i * sa) + (size_t)oa);
#pragma unroll
                for (int i = 0; i < 4; ++i) rb[i] = *(const u32x4*)((pb + i * sb) + (size_t)ob);
            }
#pragma unroll
            for (int kk = 0; kk < 2; ++kk) {
                bf16x8 b[4];
#pragma unroll
                for (int j = 0; j < 4; ++j) b[j] = *(const bf16x8*)(lrb + (j * 16 * LDT + kk * 32) * 2);
#pragma unroll
                for (int h = 0; h < 2; ++h) {
                    bf16x8 a[4];
#pragma unroll
                    for (int i = 0; i < 4; ++i) a[i] = *(const bf16x8*)(lra + ((h * 4 + i) * 16 * LDT + kk * 32) * 2);
#pragma unroll
                    for (int j = 0; j < 4; ++j)
#pragma unroll
                        for (int i = 0; i < 4; ++i) acc[h][i][j] = mfma16(b[j], a[i], acc[h][i][j]);
                }
            }
        }
        epi(bt, pm * 256 + wm * 128, pn * 128 + wn * 64, acc[0], lane);
        epi(bt, pm * 256 + wm * 128 + 64, pn * 128 + wn * 64, acc[1], lane);
    }
}
#ifndef GBKD
#define GBKD 128
#endif
template <class Epi>
__device__ __forceinline__ void gemm_phase(const GA& g, Epi epi, char* smem) {
    if (g.nbatch <= 2 && (g.M & 255) == 0 && g.K2 == 0) gemm256(g, epi, smem);
    else gemm_phase_t<GBKD>(g, epi, smem);
}

#define EPI_SIG int bt, int row0, int col0, f32x4(&acc)[4][4], int lane
#define EPI_FOR                                   \
    _Pragma("unroll") for (int i = 0; i < 4; ++i) \
        _Pragma("unroll") for (int j = 0; j < 4; ++j)
#define EPI_RC                                  \
    if (j == 0) asm volatile("" ::: "memory");   \
    const int row = row0 + i * 16 + (lane & 15); \
    const int col = col0 + j * 16 + (lane >> 4) * 4;

__device__ __forceinline__ void ln_phase(const float* __restrict__ pre, const float* __restrict__ g, const float* __restrict__ bta,
                         float* __restrict__ xout, bf16_t* __restrict__ xm, const float* __restrict__ modn, int sh_off, int sc_off) {
    int tidl = threadIdx.x;
    asm volatile("" : "+v"(tidl));
    const int lane = tidl & 63, w = tidl >> 6;
    for (int r = blockIdx.x * 4 + w; r < SEQ; r += gridDim.x * 4) {
        f32x4 v[2][4];
        float s[2] = {0.f, 0.f};
#pragma unroll
        for (int h = 0; h < 2; ++h)
#pragma unroll
            for (int i = 0; i < 4; ++i) {
                v[h][i] = *(const f32x4*)(pre + (size_t)(r + h * SEQ) * 1024 + (i * 64 + lane) * 4);
                s[h] += (v[h][i][0] + v[h][i][1]) + (v[h][i][2] + v[h][i][3]);
            }
#pragma unroll
        for (int o = 32; o > 0; o >>= 1) { s[0] += __shfl_xor(s[0], o); s[1] += __shfl_xor(s[1], o); }
        float q[2] = {0.f, 0.f};
#pragma unroll
        for (int h = 0; h < 2; ++h) {
            const float mean = s[h] * (1.f / 1024.f);
#pragma unroll
            for (int i = 0; i < 4; ++i) {
                v[h][i] = v[h][i] - mean;
                q[h] += (v[h][i][0] * v[h][i][0] + v[h][i][1] * v[h][i][1]) + (v[h][i][2] * v[h][i][2] + v[h][i][3] * v[h][i][3]);
            }
        }
#pragma unroll
        for (int o = 32; o > 0; o >>= 1) { q[0] += __shfl_xor(q[0], o); q[1] += __shfl_xor(q[1], o); }
#pragma unroll
        for (int i = 0; i < 4; ++i) {
            const int c = (i * 64 + lane) * 4;
            const f32x4 gg = *(const f32x4*)(g + c), bb = *(const f32x4*)(bta + c);
#pragma unroll
            for (int h = 0; h < 2; ++h) {
                const float rstd = rsqrtf(q[h] * (1.f / 1024.f) + 1e-5f);
                const f32x4 y = v[h][i] * rstd * gg + bb;
                *(f32x4*)(xout + (size_t)(r + h * SEQ) * 1024 + c) = y;
                if (xm) {
                    const f32x4 sc = *(const f32x4*)(modn + h * 6144 + sc_off + c), sh = *(const f32x4*)(modn + h * 6144 + sh_off + c);
                    const f32x4 ym = y * (sc + 1.f) + sh;
                    *(uint2*)(xm + (size_t)(r + h * SEQ) * 1024 + c) = pack4(ym);
                }
            }
        }
    }
}

struct EpiResid {
    float* pre; const float* x; const float* gate;
    __device__ __forceinline__ void operator()(EPI_SIG) const {
        EPI_FOR {
            EPI_RC
            const int tok = bt * SEQ + row;
            const int b = tok >> 13;
            const float4 xv = *(const float4*)(x + (size_t)tok * 1024 + col);
            const float4 gv = *(const float4*)(gate + b * 6144 + col);
            float4 o;
            o.x = DN_ALPHA * xv.x + (1.f + gv.x) * acc[i][j][0];
            o.y = DN_ALPHA * xv.y + (1.f + gv.y) * acc[i][j][1];
            o.z = DN_ALPHA * xv.z + (1.f + gv.z) * acc[i][j][2];
            o.w = DN_ALPHA * xv.w + (1.f + gv.w) * acc[i][j][3];
            *(float4*)(pre + (size_t)tok * 1024 + col) = o;
        }
    }
};
template <int ACT>
struct EpiStore {
    bf16_t* O; long ldo; float scale;
    __device__ __forceinline__ void operator()(EPI_SIG) const {
        EPI_FOR {
            EPI_RC
            f32x4 v = acc[i][j];
            if (ACT == 1) { v[0] = gelu_f(v[0]); v[1] = gelu_f(v[1]); v[2] = gelu_f(v[2]); v[3] = gelu_f(v[3]); }
            v = v * scale;
            *(uint2*)(O + (size_t)row * ldo + col) = pack4(v);
        }
    }
};

__device__ __forceinline__ void ffn_layer(const P& p, int l, const float* xres, const XcdBarrier& xb, char* smem, bool last) {
    bf16_t* WTF = (bf16_t*)(p.ws + OFF_WTFFN);
    float* MOD = (float*)(p.ws + OFF_SMALL) + 4096;
    bf16_t* XM = (bf16_t*)(p.ws + OFF_XM);
    bf16_t* ACT = (bf16_t*)(p.ws + OFF_SCR);
    float* HG = (float*)(p.ws + OFF_SCR + 96 * MIB);
    float* HU = (float*)(p.ws + OFF_SCR + 108 * MIB);
    float* PRE2 = (float*)(p.ws + OFF_PRE);
    const float* cw = p.ffn_conv_w + (size_t)l * 3 * 2816;
    const float* cb = p.ffn_conv_b + (size_t)l * 2816;
    {
        GA g = ga_make(XM, 1024, WTF, 1024, TOK, 5632, 1024);
        auto e = [=](EPI_SIG) {
            const int fr = lane & 15, fq = lane >> 4;
            const int cb0 = (col0 >> 1) + fq * 4;
            const int grp = row0 >> 6;
#pragma unroll
            for (int j = 0; j < 2; ++j) {
                const int c = cb0 + j * 16;
                const f32x4 w0a = *(const f32x4*)(cw + c), w1a = *(const f32x4*)(cw + 2816 + c), w2a = *(const f32x4*)(cw + 5632 + c), bba = *(const f32x4*)(cb + c);
#pragma unroll
                for (int i = 0; i < 4; ++i) {
                    const int tok = row0 + i * 16 + fr;
                    f32x4 o;
#pragma unroll
                    for (int e4 = 0; e4 < 4; ++e4) {
                        const float gcur = acc[i][j][e4];
                        const float gprv = (i > 0) ? acc[i > 0 ? i - 1 : 0][j][e4] : 0.f;
                        const float c1 = __int_as_float(__builtin_amdgcn_update_dpp(0, __float_as_int(gcur), 0x121, 0xf, 0xf, false));
                        const float c2 = __int_as_float(__builtin_amdgcn_update_dpp(0, __float_as_int(gcur), 0x122, 0xf, 0xf, false));
                        const float q1 = __int_as_float(__builtin_amdgcn_update_dpp(0, __float_as_int(gprv), 0x121, 0xf, 0xf, false));
                        const float q2 = __int_as_float(__builtin_amdgcn_update_dpp(0, __float_as_int(gprv), 0x122, 0xf, 0xf, false));
                        const float p1 = (fr >= 1) ? c1 : q1, p2 = (fr >= 2) ? c2 : q2;
                        const float y = w2a[e4] * gcur + w1a[e4] * p1 + w0a[e4] * p2 + bba[e4];
                        o[e4] = silu_f(y) * acc[i][j + 2][e4];
                    }
                    if (i > 0 || fr >= 2) *(uint2*)(ACT + (size_t)tok * 2816 + c) = pack4(o);
                    if (i == 0 && fr < 2) {
                        *(float4*)(HG + ((size_t)grp * 4 + 2 + fr) * 2816 + c) = make_float4(acc[0][j][0], acc[0][j][1], acc[0][j][2], acc[0][j][3]);
                        *(float4*)(HU + ((size_t)grp * 2 + fr) * 2816 + c) = make_float4(acc[0][j + 2][0], acc[0][j + 2][1], acc[0][j + 2][2], acc[0][j + 2][3]);
                    }
                    if (i == 3 && fr >= 14)
                        *(float4*)(HG + ((size_t)grp * 4 + (fr - 14)) * 2816 + c) = make_float4(acc[3][j][0], acc[3][j][1], acc[3][j][2], acc[3][j][3]);
                }
            }
        };
        GEMM_BIG(g, e, smem);
    }
    GSYNC;
    {
        int tidl = threadIdx.x;
        asm volatile("" : "+v"(tidl));
        for (int it = blockIdx.x * 256 + tidl; it < 256 * 2 * 704; it += gridDim.x * 256) {
            const int c = (it % 704) * 4, gr = it / 704, r = gr & 1, grp = gr >> 1;
            const int tok = grp * 64 + r, ts = tok & (SEQ - 1);
            const f32x4 z4 = (f32x4){0.f, 0.f, 0.f, 0.f};
            const f32x4 g0 = *(const f32x4*)(HG + ((size_t)grp * 4 + 2 + r) * 2816 + c);
            const int gp = grp > 0 ? grp - 1 : 0;
            const f32x4 h62 = *(const f32x4*)(HG + ((size_t)gp * 4 + 0) * 2816 + c);
            const f32x4 h63 = *(const f32x4*)(HG + ((size_t)gp * 4 + 1) * 2816 + c);
            const f32x4 h0 = *(const f32x4*)(HG + ((size_t)grp * 4 + 2) * 2816 + c);
            const f32x4 p1 = (r == 0) ? ((ts >= 1) ? h63 : z4) : h0;
            const f32x4 p2 = (r == 0) ? ((ts >= 2) ? h62 : z4) : ((ts >= 2) ? h63 : z4);
            const f32x4 up = *(const f32x4*)(HU + ((size_t)grp * 2 + r) * 2816 + c);
            const f32x4 w0 = *(const f32x4*)(cw + c), w1 = *(const f32x4*)(cw + 2816 + c), w2 = *(const f32x4*)(cw + 5632 + c), bb = *(const f32x4*)(cb + c);
            f32x4 o;
#pragma unroll
            for (int q = 0; q < 4; ++q) o[q] = silu_f(w2[q] * g0[q] + w1[q] * p1[q] + w0[q] * p2[q] + bb[q]) * up[q];
            *(uint2*)(ACT + (size_t)tok * 2816 + c) = pack4(o);
        }
    }
    GSYNC;
    {
        GA g = ga_make(ACT, 2816, WTF + 5632 * 1024, 2816, TOK, 1024, 2816);
        EpiResid e{PRE2, xres, MOD + l * 12288 + 5120};
        GEMM_BIG(g, e, smem);
    }
    GSYNC;
    {
        const float* modn = MOD + (l + 1) * 12288;
        ln_phase(PRE2, p.ln_g + (l * 2 + 1) * 1024, p.ln_b + (l * 2 + 1) * 1024, p.out, last ? nullptr : XM, modn, 0, 1024);
        if (!last) convert_layer(p, l + 1, smem);
    }
    GSYNC;
}

__device__ __forceinline__ void mixer_ln(const P& p, int l, const float* pre) {
    float* MOD = (float*)(p.ws + OFF_SMALL) + 4096;
    bf16_t* XM = (bf16_t*)(p.ws + OFF_XM);
    ln_phase(pre, p.ln_g + (l * 2) * 1024, p.ln_b + (l * 2) * 1024, p.out, XM, MOD + l * 12288, 3072, 4096);
}

template <int C>
struct SolveRow {
    static __device__ __forceinline__ void run(float (&sol)[64], const float* kks, const bf16_t* srcp, const float* bs, const float* gcs, bool isv) {
        float a = sol[C] * bs[C];
        if (!isv) a *= __expf(gcs[C]);
        float a1 = 0.f, a2 = 0.f, a3 = 0.f;
#pragma unroll
        for (int m = 0; m < C; ++m) {
            const float pr = kks[C * 64 + m] * sol[m];
            if ((m & 3) == 0) a -= pr; else if ((m & 3) == 1) a1 -= pr; else if ((m & 3) == 2) a2 -= pr; else a3 -= pr;
        }
        a = (a + a1) + (a2 + a3);
        asm volatile("" : "+v"(a) : : "memory");
        sol[C] = a;
        SolveRow<C + 1>::run(sol, kks, srcp, bs, gcs, isv);
    }
};
template <>
struct SolveRow<64> {
    static __device__ __forceinline__ void run(float (&)[64], const float*, const bf16_t*, const float*, const float*, bool) {}
};

extern "C" __global__ void __launch_bounds__(256, 2) mega(P p) {
    cg::grid_group grid = cg::this_grid();
    __shared__ __attribute__((aligned(16))) char smem[73728];
    __shared__ uint4 xb_words;
    const int tid = threadIdx.x, lane = tid & 63, wv = tid >> 6;
    if (tid == 0) xb_words = make_uint4(0u, 0u, 0u, 0u);
    __syncthreads();
    const XcdBarrier xb = xcd_barrier_post((unsigned*)(p.ws + OFF_BAR), (volatile LAS unsigned*)&xb_words);
    bf16_t* WTM = (bf16_t*)(p.ws + OFF_WTMIX);
    float* EV = (float*)(p.ws + OFF_SMALL);
    float* MOD = (float*)(p.ws + OFF_SMALL) + 4096;
    bf16_t* WSB = (bf16_t*)(p.ws + OFF_SMALL + 512 * 1024);
    float* COS = (float*)(p.ws + OFF_COS);
    float* SIN = (float*)(p.ws + OFF_SIN);
    float* PRE = (float*)(p.ws + OFF_PRE);
    bf16_t* XM = (bf16_t*)(p.ws + OFF_XM);
    char* SCR = p.ws + OFF_SCR;

    convert_layer(p, 0, smem);
    {
        float* red = (float*)smem;
        for (int rep = 0; rep < REP_P0; ++rep)
        for (int t = blockIdx.x; t < 64; t += gridDim.x) {
            const int col = t * 16 + (tid & 15), ks = tid >> 4;
            float a0 = 0.f, a1 = 0.f;
#pragma unroll 8
            for (int k = ks * 64; k < ks * 64 + 64; ++k) {
                const float wv_ = p.cond_w[(size_t)k * 1024 + col];
                a0 += p.c[k] * wv_;
                a1 += p.c[1024 + k] * wv_;
            }
            __syncthreads();
            red[tid * 2] = a0; red[tid * 2 + 1] = a1;
            __syncthreads();
            if (tid < 32) {
                const int c = tid & 15, b = tid >> 4;
                float sm = 0.f;
                for (int q = 0; q < 16; ++q) sm += red[(q * 16 + c) * 2 + b];
                const int cc = t * 16 + c;
                EV[b * 1024 + cc] = silu_f(sm + p.cond_b[cc]);
            }
        }
    }
    for (int rep = 0; rep < REP_P0; ++rep)
    for (int it = blockIdx.x * 256 + tid; it < SEQ * 128; it += gridDim.x * 256) {
        const int pos = it >> 7, i = it & 127;
        double f = 1.0;
        const double r = 0.9300449458481391823675;
        for (int q = 0; q < i; ++q) f *= r;
        double rev = (double)pos * f * 0.1591549430918953357689;
        rev -= floor(rev);
        const float fr = (float)rev;
        COS[it] = __builtin_amdgcn_cosf(fr);
        SIN[it] = __builtin_amdgcn_sinf(fr);
    }
    for (int it = blockIdx.x * 256 + tid; it < TOK * 2; it += gridDim.x * 256) ((float*)(p.ws + OFF_STATS))[it] = 0.f;
    for (int it = blockIdx.x * 256 + tid; it < 8 * 128 * 128; it += gridDim.x * 256) {
        const int s = it & 127, t = (it >> 7) & 127;
        WSB[it] = (s <= t) ? f2bf(p.gmlp_w_s[it]) : (bf16_t)0;
    }
    if (p.ws == nullptr) grid.sync();
    GSYNC;
    {
        float* red = (float*)smem;
        for (int rep = 0; rep < REP_P0; ++rep)
        for (int t = blockIdx.x; t < 1536; t += gridDim.x) {
            const int l = t / 384, cgp = t - l * 384;
            const int col = cgp * 16 + (tid & 15), ks = tid >> 4;
            const float* wp = p.ada_w + (size_t)l * 1024 * 6144 + col;
            float a0 = 0.f, a1 = 0.f;
#pragma unroll 8
            for (int k = ks * 64; k < ks * 64 + 64; ++k) {
                const float wv_ = wp[(size_t)k * 6144];
                a0 += EV[k] * wv_;
                a1 += EV[1024 + k] * wv_;
            }
            __syncthreads();
            red[tid * 2] = a0; red[tid * 2 + 1] = a1;
            __syncthreads();
            if (tid < 32) {
                const int c = tid & 15, b = tid >> 4;
                float sm = 0.f;
                for (int q = 0; q < 16; ++q) sm += red[(q * 16 + c) * 2 + b];
                const int cc = cgp * 16 + c;
                MOD[l * 12288 + b * 6144 + cc] = sm + p.ada_b[l * 6144 + cc];
            }
        }
    }
    GSYNC;
    { LOCAL_TID
    for (int it = blockIdx.x * 256 + tid; it < TOK * 256; it += gridDim.x * 256) {
        const int tok = it >> 8, c = (it & 255) * 4, b = tok >> 13;
        const float4 xv = *(const float4*)(p.x + (size_t)tok * 1024 + c);
        const float4 sh = *(const float4*)(MOD + b * 6144 + c), sc = *(const float4*)(MOD + b * 6144 + 1024 + c);
        uint2 o;
        o.x = pack2(xv.x * (1.f + sc.x) + sh.x, xv.y * (1.f + sc.y) + sh.y);
        o.y = pack2(xv.z * (1.f + sc.z) + sh.z, xv.w * (1.f + sc.w) + sh.w);
        *(uint2*)(XM + (size_t)tok * 1024 + c) = o;
    }
    }
    GSYNC;

    {
        bf16_t* QKV = (bf16_t*)SCR;
        bf16_t* Z = (bf16_t*)(SCR + 96 * MIB);
        float* AB = (float*)(SCR + 128 * MIB);
        float* BETA = (float*)(SCR + 129 * MIB);
        float* GC = (float*)(SCR + 130 * MIB);
        float* KK = (float*)(SCR + 131 * MIB);
        bf16_t* QKb = (bf16_t*)(SCR + 163 * MIB);
        bf16_t* Qn = (bf16_t*)(p.ws + OFF_PRE);
        bf16_t* Kn = (bf16_t*)(p.ws + OFF_PRE + 32 * MIB);
        bf16_t* Vc = XM;
        bf16_t* U = (bf16_t*)SCR;
        bf16_t* W = (bf16_t*)(SCR + 32 * MIB);
        bf16_t* KDT = (bf16_t*)(SCR + 64 * MIB);
        bf16_t* O = XM;
        {
            GA g = ga_make(XM, 1024, WTM, 1024, TOK, 3072, 1024);
            EpiStore<0> e{QKV, 3072, 1.f};
            gemm_phase(g, e, smem);
            GA g2 = ga_make(XM, 1024, WTM + 3072 * 1024, 1024, TOK, 1024, 1024);
            EpiStore<0> e2{Z, 1024, 1.f};
            gemm_phase(g2, e2, smem);
            GA g3 = ga_make(XM, 1024, WTM + 4096 * 1024, 1024, TOK, 128, 1024);
            auto e3 = [=](EPI_SIG) {
#pragma unroll
                for (int i = 0; i < 4; ++i) {
                    const int row = row0 + i * 16 + (lane & 15);
                    const int col = col0 + (lane >> 4) * 4;
                    if (col0 == 0) *(float4*)(AB + (size_t)row * 16 + col) = make_float4(acc[i][0][0], acc[i][0][1], acc[i][0][2], acc[i][0][3]);
                }
            };
            gemm_phase(g3, e3, smem);
        }
        GSYNC;
        {
            LOCAL_TID
            float* gs = (float*)smem;
            for (int rep = 0; rep < REP_GB; ++rep)
            for (int t = blockIdx.x; t < 1536; t += gridDim.x) {
                const int ct = t / 6, sg = t - ct * 6;
                const int tokw = ct * 64 + wv * 16;
                const int ts = tokw & (SEQ - 1);
                for (int s4 = 0; s4 < 4; ++s4) {
                    const int seg = sg * 4 + s4;
                    const int ch = seg * 128 + lane * 2;
                    const float2 w0 = *(const float2*)(p.gdn_conv_w + ch), w1 = *(const float2*)(p.gdn_conv_w + 3072 + ch),
                                 w2 = *(const float2*)(p.gdn_conv_w + 2 * 3072 + ch), w3 = *(const float2*)(p.gdn_conv_w + 3 * 3072 + ch);
                    unsigned x0 = 0, x1 = 0, x2 = 0;
                    if (ts >= 3) {
                        x0 = *(const unsigned*)(QKV + (size_t)(tokw - 3) * 3072 + ch);
                        x1 = *(const unsigned*)(QKV + (size_t)(tokw - 2) * 3072 + ch);
                        x2 = *(const unsigned*)(QKV + (size_t)(tokw - 1) * 3072 + ch);
                    }
                    unsigned xr[16];
#pragma unroll
                    for (int i = 0; i < 16; ++i) xr[i] = *(const unsigned*)(QKV + (size_t)(tokw + i) * 3072 + ch);
                    float y0[16], y1[16], ss[16];
#pragma unroll
                    for (int i = 0; i < 16; ++i) {
                        const unsigned x3 = xr[i];
                        y0[i] = silu_f(w3.x * lo16(x3) + w2.x * lo16(x2) + w1.x * lo16(x1) + w0.x * lo16(x0));
                        y1[i] = silu_f(w3.y * hi16(x3) + w2.y * hi16(x2) + w1.y * hi16(x1) + w0.y * hi16(x0));
                        x0 = x1; x1 = x2; x2 = x3;
                        ss[i] = y0[i] * y0[i] + y1[i] * y1[i];
                    }
                    if (seg < 16) {
#pragma unroll
                        for (int o = 32; o > 0; o >>= 1)
#pragma unroll
                            for (int i = 0; i < 16; ++i) ss[i] += __shfl_xor(ss[i], o);
                        const float qs = (seg < 8) ? 0.08838834764831845f : 1.f;
#pragma unroll
                        for (int i = 0; i < 16; ++i) {
                            const float r = rsqrtf(ss[i] + 1e-6f) * qs;
                            y0[i] *= r; y1[i] *= r;
                        }
                    }
                    bf16_t* dst = (seg < 8) ? (Qn + (size_t)tokw * 1024 + ch) : (seg < 16) ? (Kn + (size_t)tokw * 1024 + (ch - 1024)) : (Vc + (size_t)tokw * 1024 + (ch - 2048));
#pragma unroll
                    for (int i = 0; i < 16; ++i) *(unsigned*)(dst + (size_t)i * 1024) = pack2(y0[i], y1[i]);
                }
                if (sg == 0) {
                    __syncthreads();
                    if (lane < 8) {
                        const float al = __expf(p.gdn_a_log[lane]), dtb = p.gdn_dt_bias[lane];
                        for (int i = 0; i < 16; ++i) {
                            const int tok = tokw + i;
                            const float a = AB[(size_t)tok * 16 + lane], btv = AB[(size_t)tok * 16 + 8 + lane];
                            BETA[(size_t)tok * 8 + lane] = sigmoid_f(btv);
                            gs[(wv * 16 + i) * 8 + lane] = -al * softplus_f(a + dtb);
                        }
                    }
                    __syncthreads();
                    if (tid < 8) {
                        float run = 0.f;
                        for (int i = 0; i < 64; ++i) {
                            run += gs[i * 8 + tid];
                            GC[(size_t)(ct * 64 + i) * 8 + tid] = run;
                        }
                    }
                }
            }
        }
        GSYNC;
        {
            GA g = ga_make(Kn, 1024, Kn, 1024, 128, 128, 128);
            g.nbatch = 128 * 8; g.bdiv = 8; g.a_o = 131072; g.a_i = 128; g.b_o = 131072; g.b_i = 128;
            auto ekk = [=](EPI_SIG) {
                const int bo = bt >> 3, h = bt & 7;
                EPI_FOR {
                    EPI_RC
                    if ((row >> 6) == (col >> 6)) {
                        const int tokr = bo * 128 + row;
                        const float gr = GC[(size_t)tokr * 8 + h], br = BETA[(size_t)tokr * 8 + h];
                        float o[4];
#pragma unroll
                        for (int e = 0; e < 4; ++e) {
                            const int cc = col + e;
                            const float gcv = GC[(size_t)(bo * 128 + cc) * 8 + h];
                            o[e] = (cc < row) ? acc[i][j][e] * br * __expf(gr - gcv) : 0.f;
                        }
                        *(float4*)(KK + ((size_t)tokr * 8 + h) * 64 + (col & 63)) = make_float4(o[0], o[1], o[2], o[3]);
                    }
                }
            };
            gemm_phase(g, ekk, smem);
            GA g2 = g; g2.A = Qn; g2.A2 = Qn;
            auto eqk = [=](EPI_SIG) {
                const int bo = bt >> 3, h = bt & 7;
                EPI_FOR {
                    EPI_RC
                    if ((row >> 6) == (col >> 6)) {
                        const int tokr = bo * 128 + row;
                        const float gr = GC[(size_t)tokr * 8 + h];
                        f32x4 o;
#pragma unroll
                        for (int e = 0; e < 4; ++e) {
                            const int cc = col + e;
                            const float gcv = GC[(size_t)(bo * 128 + cc) * 8 + h];
                            o[e] = (cc <= row) ? acc[i][j][e] * __expf(gr - gcv) : 0.f;
                        }
                        *(uint2*)(QKb + ((size_t)tokr * 8 + h) * 64 + (col & 63)) = pack4(o);
                    }
                }
            };
            gemm_phase(g2, eqk, smem);
        }
        GSYNC;
#ifndef NO_D
        {
            LOCAL_TID
            float* kks = (float*)smem;
            bf16_t* kdl = (bf16_t*)(smem + 16384);
            float* bs = (float*)(smem + 16384 + 17408);
            float* gcs = bs + 64;
            for (int rep = 0; rep < REP_GD; ++rep)
            for (int t = blockIdx.x; t < 2048; t += gridDim.x) {
                const int cn = t >> 3, h = t & 7, tok0 = cn * 64;
                __syncthreads();
#pragma unroll
                for (int i = 0; i < 16; ++i) {
                    const int idx = tid + i * 256, c = idx >> 6, m = idx & 63;
                    kks[idx] = KK[((size_t)(tok0 + c) * 8 + h) * 64 + m];
                }
                if (tid < 64) { bs[tid] = BETA[(size_t)(tok0 + tid) * 8 + h]; gcs[tid] = GC[(size_t)(tok0 + tid) * 8 + h]; }
                __syncthreads();
                const bool isv = tid < 128;
                const bf16_t* srcp = isv ? (Vc + (size_t)tok0 * 1024 + h * 128 + tid) : (Kn + (size_t)tok0 * 1024 + h * 128 + (tid - 128));
                float sol[64];
#pragma unroll
                for (int c = 0; c < 64; ++c) sol[c] = bf2f(srcp[(size_t)c * 1024]);
                SolveRow<0>::run(sol, kks, srcp, bs, gcs, isv);
                bf16_t* dstp = isv ? (U + (size_t)tok0 * 1024 + h * 128 + tid) : (W + (size_t)tok0 * 1024 + h * 128 + (tid - 128));
#pragma unroll
                for (int c = 0; c < 64; ++c) dstp[(size_t)c * 1024] = f2bf(sol[c]);
                {
                    const int dk = tid & 127, half = tid >> 7;
                    const float gl = gcs[63];
                    for (int c = half * 32; c < half * 32 + 32; ++c)
                        kdl[c * 136 + dk] = f2bf(bf2f(Kn[(size_t)(tok0 + c) * 1024 + h * 128 + dk]) * __expf(gl - gcs[c]));
                }
                __syncthreads();
                {
                    const int dk = tid >> 1, hf = tid & 1;
                    bf16_t* dp = KDT + ((size_t)(cn * 8 + h) * 128 + dk) * 64 + hf * 32;
#pragma unroll
                    for (int c8 = 0; c8 < 4; ++c8) {
                        unsigned u4[4];
#pragma unroll
                        for (int q = 0; q < 4; ++q) {
                            const int c = hf * 32 + c8 * 8 + q * 2;
                            u4[q] = (unsigned)kdl[c * 136 + dk] | ((unsigned)kdl[(c + 1) * 136 + dk] << 16);
                        }
                        *(uint4*)(dp + c8 * 8) = make_uint4(u4[0], u4[1], u4[2], u4[3]);
                    }
                }
            }
        }
#endif
        GSYNC;
#ifndef NO_E
        {
            LOCAL_TID
            bf16_t* ST = (bf16_t*)smem;
            bf16_t* WC = ST + 16 * 136;
            bf16_t* QC = WC + 64 * 136;
            bf16_t* QKC = QC + 64 * 136;
            bf16_t* KDS = QKC + 64 * 72;
            bf16_t* VNT = KDS + 128 * 72;
            const int fr = lane & 15, fq = lane >> 4;
            for (int rep = 0; rep < REP_E; ++rep)
            for (int t = blockIdx.x; t < 128; t += gridDim.x) {
                const int b = t >> 6, h = (t >> 3) & 7, sl = t & 7;
                const int dv0 = h * 128 + sl * 16;
                f32x4 sacc[2];
                sacc[0] = (f32x4){0.f, 0.f, 0.f, 0.f}; sacc[1] = sacc[0];
                __syncthreads();
                for (int i = tid; i < 16 * 136; i += 256) ST[i] = 0;
                u32x4 pw[4], pq[4], pqk[2], pkd[4];
                float pu[4], pgc[4], pgl;
#define SCAN_ISSUE(nn)                                                                                                   \
    {                                                                                                                    \
        const int cn_ = b * 128 + (nn), tk_ = cn_ * 64;                                                                  \
        _Pragma("unroll") for (int i = 0; i < 4; ++i) {                                                                  \
            const int id = tid + i * 256, r = id >> 4, kc = (id & 15) * 8;                                               \
            pw[i] = *(const u32x4*)(W + (size_t)(tk_ + r) * 1024 + h * 128 + kc);                                        \
            pq[i] = *(const u32x4*)(Qn + (size_t)(tk_ + r) * 1024 + h * 128 + kc);                                       \
        }                                                                                                                \
        _Pragma("unroll") for (int i = 0; i < 2; ++i) {                                                                  \
            const int id = tid + i * 256, r = id >> 3, kc = (id & 7) * 8;                                                \
            pqk[i] = *(const u32x4*)(QKb + ((size_t)(tk_ + r) * 8 + h) * 64 + kc);                                       \
        }                                                                                                                \
        _Pragma("unroll") for (int i = 0; i < 4; ++i) {                                                                  \
            const int id = tid + i * 256, r = id >> 3, kc = (id & 7) * 8;                                                \
            pkd[i] = *(const u32x4*)(KDT + ((size_t)(cn_ * 8 + h) * 128 + r) * 64 + kc);                                \
        }                                                                                                                \
        _Pragma("unroll") for (int e = 0; e < 4; ++e) {                                                                  \
            const int tok = tk_ + wv * 16 + fq * 4 + e;                                                                  \
            pu[e] = bf2f(U[(size_t)tok * 1024 + dv0 + fr]);                                                              \
            pgc[e] = GC[(size_t)tok * 8 + h];                                                                            \
        }                                                                                                                \
        pgl = GC[(size_t)(tk_ + 63) * 8 + h];                                                                            \
    }
                SCAN_ISSUE(0)
                for (int n = 0; n < 128; ++n) {
                    const int cn = b * 128 + n, tok0 = cn * 64;
                    __syncthreads();
#pragma unroll
                    for (int i = 0; i < 4; ++i) {
                        const int id = tid + i * 256, r = id >> 4, kc = (id & 15) * 8;
                        *(u32x4*)(WC + r * 136 + kc) = pw[i];
                        *(u32x4*)(QC + r * 136 + kc) = pq[i];
                    }
#pragma unroll
                    for (int i = 0; i < 2; ++i) {
                        const int id = tid + i * 256, r = id >> 3, kc = (id & 7) * 8;
                        *(u32x4*)(QKC + r * 72 + kc) = pqk[i];
                    }
#pragma unroll
                    for (int i = 0; i < 4; ++i) {
                        const int id = tid + i * 256, r = id >> 3, kc = (id & 7) * 8;
                        *(u32x4*)(KDS + r * 72 + kc) = pkd[i];
                    }
                    float ucur[4], gcr[4];
#pragma unroll
                    for (int e = 0; e < 4; ++e) { ucur[e] = pu[e]; gcr[e] = pgc[e]; }
                    const float glc = pgl;
                    __syncthreads();
                    if (n + 1 < 128) SCAN_ISSUE(n + 1)
                    const int c0 = wv * 16;
                    f32x4 wsv = (f32x4){0.f, 0.f, 0.f, 0.f}, o1 = wsv;
#pragma unroll
                    for (int kk = 0; kk < 4; ++kk) {
                        const bf16x8 a = *(const bf16x8*)(WC + (c0 + fr) * 136 + kk * 32 + fq * 8);
                        const bf16x8 q = *(const bf16x8*)(QC + (c0 + fr) * 136 + kk * 32 + fq * 8);
                        const bf16x8 s = *(const bf16x8*)(ST + fr * 136 + kk * 32 + fq * 8);
                        wsv = mfma16(a, s, wsv);
                        o1 = mfma16(q, s, o1);
                    }
                    f32x4 vn;
#pragma unroll
                    for (int e = 0; e < 4; ++e) vn[e] = ucur[e] - wsv[e];
                    *(uint2*)(VNT + fr * 72 + c0 + fq * 4) = pack4(vn);
                    __syncthreads();
                    f32x4 o2 = (f32x4){0.f, 0.f, 0.f, 0.f};
#pragma unroll
                    for (int kk = 0; kk < 2; ++kk) {
                        const bf16x8 a = *(const bf16x8*)(QKC + (c0 + fr) * 72 + kk * 32 + fq * 8);
                        const bf16x8 v = *(const bf16x8*)(VNT + fr * 72 + kk * 32 + fq * 8);
                        o2 = mfma16(a, v, o2);
                    }
#pragma unroll
                    for (int e = 0; e < 4; ++e) {
                        const int tok = tok0 + c0 + fq * 4 + e;
                        O[(size_t)tok * 1024 + dv0 + fr] = f2bf(o1[e] * __expf(gcr[e]) + o2[e]);
                    }
                    const float eg = __expf(glc);
#pragma unroll
                    for (int tt = 0; tt < 2; ++tt) {
                        const int mt = wv * 2 + tt;
                        f32x4 d = (f32x4){0.f, 0.f, 0.f, 0.f};
#pragma unroll
                        for (int kk = 0; kk < 2; ++kk) {
                            const bf16x8 a = *(const bf16x8*)(KDS + (mt * 16 + fr) * 72 + kk * 32 + fq * 8);
                            const bf16x8 v = *(const bf16x8*)(VNT + fr * 72 + kk * 32 + fq * 8);
                            d = mfma16(a, v, d);
                        }
                        sacc[tt] = sacc[tt] * eg + d;
                        *(uint2*)(ST + fr * 136 + mt * 16 + fq * 4) = pack4(sacc[tt]);
                    }
                }
            }
        }
#endif
        GSYNC;
        { LOCAL_TID
        for (int tok = blockIdx.x * 4 + wv; tok < TOK; tok += gridDim.x * 4) {
            unsigned ov[8], zv[8];
            float ss[8];
#pragma unroll
            for (int h = 0; h < 8; ++h) {
                ov[h] = *(const unsigned*)(O + (size_t)tok * 1024 + h * 128 + lane * 2);
                zv[h] = *(const unsigned*)(Z + (size_t)tok * 1024 + h * 128 + lane * 2);
                ss[h] = lo16(ov[h]) * lo16(ov[h]) + hi16(ov[h]) * hi16(ov[h]);
            }
#pragma unroll
            for (int o = 32; o > 0; o >>= 1)
#pragma unroll
                for (int h = 0; h < 8; ++h) ss[h] += __shfl_xor(ss[h], o);
            const float2 nw = *(const float2*)(p.gdn_norm_w + lane * 2);
#pragma unroll
            for (int h = 0; h < 8; ++h) {
                const float r = rsqrtf(ss[h] * (1.f / 128.f) + 1e-6f);
                *(unsigned*)(O + (size_t)tok * 1024 + h * 128 + lane * 2) =
                    pack2(lo16(ov[h]) * r * nw.x * silu_f(lo16(zv[h])), hi16(ov[h]) * r * nw.y * silu_f(hi16(zv[h])));
            }
        }
        }
        GSYNC;
        {
            GA g = ga_make(O, 1024, WTM + 4224 * 1024, 1024, TOK, 1024, 1024);
            EpiResid e{PRE, p.x, MOD + 0 * 12288 + 2048};
            gemm_phase(g, e, smem);
        }
        GSYNC;
        mixer_ln(p, 0, PRE);
        GSYNC;

    }
    ffn_layer(p, 0, p.out, xb, smem, false);
    {
        bf16_t* QX = (bf16_t*)SCR;
        bf16_t* KZT = (bf16_t*)(SCR + 32 * MIB);
        bf16_t* VT = (bf16_t*)(SCR + 64 * MIB);
        bf16_t* GATE = (bf16_t*)(SCR + 128 * MIB);
        bf16_t* Kr = (bf16_t*)(SCR + 192 * MIB);
        bf16_t* SC = (bf16_t*)(SCR + 224 * MIB);
        bf16_t* STATE = (bf16_t*)(p.ws + OFF_PRE);
        bf16_t* OR0 = XM;
        bf16_t* OR1 = Kr;
        float* PRE1 = (float*)SCR;
        float l2g[4];
#pragma unroll
        for (int h = 0; h < 4; ++h) l2g[h] = log2f(1.f - exp2f(-5.f - (float)h));
        {
            GA g = ga_make(XM, 1024, WTM, 1024, TOK, 1024, 1024);
            auto eq = [=](EPI_SIG) {
#pragma unroll
                for (int i = 0; i < 4; ++i) {
                    const int tok = row0 + i * 16 + (lane & 15);
                    const int pos = tok & (SEQ - 1), c = pos & 127;
#pragma unroll
                    for (int jp = 0; jp < 4; jp += 2) {
                        const int col = col0 + jp * 16 + (lane >> 4) * 4;
                        const int hd = col >> 8, pl = col & 255, ai = 16 * (pl >> 5) + (lane >> 4) * 4;
                        const float lg = hd == 0 ? l2g[0] : hd == 1 ? l2g[1] : hd == 2 ? l2g[2] : l2g[3];
                        const float xi = exp2f((float)(c + 1) * lg);
                        const float4 cs = *(const float4*)(COS + pos * 128 + ai), sn = *(const float4*)(SIN + pos * 128 + ai);
                        const float csa[4] = {cs.x, cs.y, cs.z, cs.w}, sna[4] = {sn.x, sn.y, sn.z, sn.w};
                        f32x4 r1, r2;
#pragma unroll
                        for (int e = 0; e < 4; ++e) {
                            const float t1 = acc[i][jp][e], t2 = acc[i][jp + 1][e];
                            r1[e] = (t1 * csa[e] - t2 * sna[e]) * xi;
                            r2[e] = (t1 * sna[e] + t2 * csa[e]) * xi;
                        }
                        *(uint2*)(QX + (size_t)tok * 1024 + col) = pack4(r1);
                        *(uint2*)(QX + (size_t)tok * 1024 + col + 16) = pack4(r2);
                    }
                }
            };
            gemm_phase(g, eq, smem);
            GA gk = ga_make(XM, 1024, WTM + 1024 * 1024, 1024, TOK, 1024, 1024);
            auto ek = [=](EPI_SIG) {
#pragma unroll
                for (int i = 0; i < 4; ++i) {
                    const int tok = row0 + i * 16 + (lane & 15);
                    const int pos = tok & (SEQ - 1), c = pos & 127, b = tok >> 13;
#pragma unroll
                    for (int jp = 0; jp < 4; jp += 2) {
                        const int col = col0 + jp * 16 + (lane >> 4) * 4;
                        const int hd = col >> 8, pl = col & 255, ai = 16 * (pl >> 5) + (lane >> 4) * 4;
                        const float lg = hd == 0 ? l2g[0] : hd == 1 ? l2g[1] : hd == 2 ? l2g[2] : l2g[3];
                        const float zeta = exp2f((float)(127 - c) * lg);
                        const float4 cs = *(const float4*)(COS + pos * 128 + ai), sn = *(const float4*)(SIN + pos * 128 + ai);
                        const float csa[4] = {cs.x, cs.y, cs.z, cs.w}, sna[4] = {sn.x, sn.y, sn.z, sn.w};
                        f32x4 r1, r2;
#pragma unroll
                        for (int e = 0; e < 4; ++e) {
                            const float t1 = acc[i][jp][e], t2 = acc[i][jp + 1][e];
                            r1[e] = (t1 * csa[e] - t2 * sna[e]) * 0.0625f;
                            r2[e] = (t1 * sna[e] + t2 * csa[e]) * 0.0625f;
                        }
                        *(uint2*)(Kr + (size_t)tok * 1024 + col) = pack4(r1);
                        *(uint2*)(Kr + (size_t)tok * 1024 + col + 16) = pack4(r2);
                        bf16_t* kz = KZT + ((size_t)(b * 4 + hd) * 256 + pl) * SEQ + pos;
#pragma unroll
                        for (int e = 0; e < 4; ++e) {
                            kz[(size_t)e * SEQ] = f2bf(r1[e] * zeta);
                            kz[(size_t)(e + 16) * SEQ] = f2bf(r2[e] * zeta);
                        }
                    }
                }
            };
            gemm_phase(gk, ek, smem);
            GA gv = ga_make(XM, 1024, WTM + 2048 * 1024, 1024, TOK, 2048, 1024);
            auto ev = [=](EPI_SIG) {
                EPI_FOR {
                    EPI_RC
                    const int pos = row & (SEQ - 1), b = row >> 13, hd = col >> 9, dv = col & 511;
                    bf16_t* vp = VT + ((size_t)(b * 4 + hd) * 512 + dv) * SEQ + pos;
#pragma unroll
                    for (int e = 0; e < 4; ++e) vp[(size_t)e * SEQ] = f2bf(acc[i][j][e]);
                }
            };
            gemm_phase(gv, ev, smem);
            GA gg = ga_make(XM, 1024, WTM + 4096 * 1024, 1024, TOK, 2048, 1024);
            EpiStore<0> eg{GATE, 2048, 1.f};
            gemm_phase(gg, eg, smem);
        }
        GSYNC;
        {
            GA g = ga_make(QX, 1024, Kr, 1024, 128, 128, 256);
            g.nbatch = 512; g.bdiv = 4; g.a_o = 131072; g.a_i = 256; g.b_o = 131072; g.b_i = 256;
            auto es = [=](EPI_SIG) {
                const int cn = bt >> 2, h = bt & 3;
                const float lg = h == 0 ? l2g[0] : h == 1 ? l2g[1] : h == 2 ? l2g[2] : l2g[3];
                EPI_FOR {
                    EPI_RC
                    f32x4 o;
#pragma unroll
                    for (int e = 0; e < 4; ++e) {
                        const int m = col + e;
                        o[e] = (m <= row) ? acc[i][j][e] * exp2f(-(float)(m + 1) * lg) : 0.f;
                    }
                    *(uint2*)(SC + ((size_t)(cn * 128 + row)) * 512 + h * 128 + col) = pack4(o);
                }
            };
            gemm_phase(g, es, smem);
        }
        for (int b = 0; b < 2; ++b) {
            {
                GA g = ga_make(VT + (size_t)b * 4 * 512 * SEQ, SEQ, KZT + (size_t)b * 4 * 256 * SEQ, SEQ, 512, 256, 128);
                g.nbatch = 256; g.bdiv = 64; g.a_o = 512 * SEQ; g.a_i = 128; g.b_o = 256 * SEQ; g.b_i = 128;
                auto e = [=](EPI_SIG) {
                    EPI_FOR {
                        EPI_RC
                        *(uint2*)(STATE + ((size_t)bt * 512 + row) * 256 + col) = pack4(acc[i][j]);
                    }
                };
                gemm_phase(g, e, smem);
            }
            GSYNC;
            {
            LOCAL_TID
                const int it = blockIdx.x * 256 + tid;
                if (it < 65536) {
                    const int h = it >> 14;
                    const float lg = h == 0 ? l2g[0] : h == 1 ? l2g[1] : h == 2 ? l2g[2] : l2g[3];
                    const float gch = exp2f(128.f * lg);
                    bf16_t* sp = STATE + (size_t)h * 64 * 131072 + (size_t)(it & 16383) * 8;
                    float st[8];
#pragma unroll
                    for (int q = 0; q < 8; ++q) st[q] = 0.f;
                    for (int n0 = 0; n0 < 64; n0 += 8) {
                        u32x4 kvb[8];
#pragma unroll
                        for (int q = 0; q < 8; ++q) kvb[q] = *(const u32x4*)(sp + (size_t)(n0 + q) * 131072);
#pragma unroll
                        for (int q = 0; q < 8; ++q) {
                            const u32x4 kv = kvb[q];
                            u32x4 o;
                            o[0] = pack2(st[0], st[1]); o[1] = pack2(st[2], st[3]); o[2] = pack2(st[4], st[5]); o[3] = pack2(st[6], st[7]);
                            *(u32x4*)(sp + (size_t)(n0 + q) * 131072) = o;
                            st[0] = st[0] * gch + lo16(kv[0]); st[1] = st[1] * gch + hi16(kv[0]);
                            st[2] = st[2] * gch + lo16(kv[1]); st[3] = st[3] * gch + hi16(kv[1]);
                            st[4] = st[4] * gch + lo16(kv[2]); st[5] = st[5] * gch + hi16(kv[2]);
                            st[6] = st[6] * gch + lo16(kv[3]); st[7] = st[7] * gch + hi16(kv[3]);
                        }
                    }
                }
            }
            GSYNC;
            {
                GA g = ga_make(QX + (size_t)b * 64 * 131072, 1024, STATE, 256, 128, 512, 256);
                g.nbatch = 256; g.bdiv = 64; g.a_o = 256; g.a_i = 131072; g.b_o = 64 * 131072; g.b_i = 131072;
                g.A2 = SC + (size_t)b * 64 * 128 * 512; g.lda2 = 512; g.a2_o = 128; g.a2_i = 128 * 512;
                g.B2 = VT + (size_t)b * 4 * 512 * SEQ; g.ldb2 = SEQ; g.b2_o = 512 * SEQ; g.b2_i = 128; g.K2 = 128;
                bf16_t* ORb = b ? OR1 : OR0;
                auto e = [=](EPI_SIG) {
                    const int h = bt >> 6, n = bt & 63;
                    EPI_FOR {
                        EPI_RC
                        *(uint2*)(ORb + ((size_t)(n * 128 + row)) * 2048 + h * 512 + col) = pack4(acc[i][j]);
                    }
                };
                gemm_phase(g, e, smem);
            }
            GSYNC;
        }
        { LOCAL_TID
        for (int tok = blockIdx.x * 4 + wv; tok < TOK; tok += gridDim.x * 4) {
            bf16_t* op = (tok >> 13) ? (OR1 + (size_t)(tok & (SEQ - 1)) * 2048) : (OR0 + (size_t)tok * 2048);
            u32x4 ov[4], gv[4];
            float sm[4], qq[4];
#pragma unroll
            for (int h = 0; h < 4; ++h) {
                ov[h] = *(const u32x4*)(op + h * 512 + lane * 8);
                gv[h] = *(const u32x4*)(GATE + (size_t)tok * 2048 + h * 512 + lane * 8);
                sm[h] = 0.f;
#pragma unroll
                for (int q = 0; q < 4; ++q) sm[h] += lo16(ov[h][q]) + hi16(ov[h][q]);
            }
#pragma unroll
            for (int o = 32; o > 0; o >>= 1)
#pragma unroll
                for (int h = 0; h < 4; ++h) sm[h] += __shfl_xor(sm[h], o);
#pragma unroll
            for (int h = 0; h < 4; ++h) {
                const float mean = sm[h] * (1.f / 512.f);
                sm[h] = mean;
                qq[h] = 0.f;
#pragma unroll
                for (int q = 0; q < 4; ++q) {
                    const float d0 = lo16(ov[h][q]) - mean, d1 = hi16(ov[h][q]) - mean;
                    qq[h] += d0 * d0 + d1 * d1;
                }
            }
#pragma unroll
            for (int o = 32; o > 0; o >>= 1)
#pragma unroll
                for (int h = 0; h < 4; ++h) qq[h] += __shfl_xor(qq[h], o);
#pragma unroll
            for (int h = 0; h < 4; ++h) {
                const float rstd = rsqrtf(qq[h] * (1.f / 512.f) + 1e-6f), mean = sm[h];
                u32x4 r;
#pragma unroll
                for (int q = 0; q < 4; ++q)
                    r[q] = pack2((lo16(ov[h][q]) - mean) * rstd * silu_f(lo16(gv[h][q])), (hi16(ov[h][q]) - mean) * rstd * silu_f(hi16(gv[h][q])));
                *(u32x4*)(op + h * 512 + lane * 8) = r;
            }
        }
        }
        GSYNC;
        {
            GA g = ga_make(OR0, 2048, WTM + 6144 * 1024, 2048, SEQ, 1024, 2048);
            g.nbatch = 2; g.bdiv = 1; g.a_o = (long)(OR1 - OR0);
            EpiResid e{PRE1, p.out, MOD + 1 * 12288 + 2048};
            gemm_phase(g, e, smem);
        }
        GSYNC;
        mixer_ln(p, 1, PRE1);
        GSYNC;

    }
    ffn_layer(p, 1, p.out, xb, smem, false);
    {
        bf16_t* Ub = (bf16_t*)SCR;
        bf16_t* VT = (bf16_t*)(SCR + 64 * MIB);
        {
            GA g = ga_make(XM, 1024, WTM, 1024, TOK, 2048, 1024);
            EpiStore<1> e{Ub, 2048, 1.f};
            gemm_phase(g, e, smem);
            GA gv = ga_make(XM, 1024, WTM + 2048 * 1024, 1024, TOK, 2048, 1024);
            float* STATS = (float*)(p.ws + OFF_STATS);
            auto ev = [=](EPI_SIG) {
#pragma unroll
                for (int i = 0; i < 4; ++i) {
                    const int row = row0 + i * 16 + (lane & 15);
                    const int cn = row >> 7, s = row & 127;
                    float sm = 0.f, sq = 0.f;
#pragma unroll
                    for (int j = 0; j < 4; ++j) {
                        const int col = col0 + j * 16 + (lane >> 4) * 4;
                        bf16_t* vp = VT + ((size_t)cn * 2048 + col) * 128 + s;
#pragma unroll
                        for (int e = 0; e < 4; ++e) {
                            const bf16_t hv = f2bf(gelu_f(acc[i][j][e]));
                            vp[(size_t)e * 128] = hv;
                            const float fv = bf2f(hv);
                            sm += fv; sq += fv * fv;
                        }
                    }
                    sm += __shfl_xor(sm, 16); sq += __shfl_xor(sq, 16);
                    sm += __shfl_xor(sm, 32); sq += __shfl_xor(sq, 32);
                    if (lane < 16) { atomicAdd(STATS + (size_t)row * 2, sm); atomicAdd(STATS + (size_t)row * 2 + 1, sq); }
                }
            };
            gemm_phase(gv, ev, smem);
        }
        GSYNC;
        {
            LOCAL_TID
            const float* STATS = (const float*)(p.ws + OFF_STATS);
            for (int it = blockIdx.x * 256 + tid; it < 128 * 2048 * 16; it += gridDim.x * 256) {
                const int s8 = it & 15, d = (it >> 4) & 2047, cn = it >> 15;
                bf16_t* vp = VT + ((size_t)cn * 2048 + d) * 128 + s8 * 8;
                const u32x4 v = *(const u32x4*)vp;
                const float* st = STATS + (size_t)(cn * 128 + s8 * 8) * 2;
                const float4 s0 = *(const float4*)st, s1 = *(const float4*)(st + 4), s2 = *(const float4*)(st + 8), s3 = *(const float4*)(st + 12);
                const float lg = p.gmlp_ln_g[d], lb = p.gmlp_ln_b[d];
                const float sums[8] = {s0.x, s0.z, s1.x, s1.z, s2.x, s2.z, s3.x, s3.z};
                const float sqs[8] = {s0.y, s0.w, s1.y, s1.w, s2.y, s2.w, s3.y, s3.w};
                float y[8];
#pragma unroll
                for (int q = 0; q < 8; ++q) {
                    const float mean = sums[q] * (1.f / 2048.f);
                    const float var = fmaxf(sqs[q] * (1.f / 2048.f) - mean * mean, 0.f);
                    const float rstd = rsqrtf(var + 1e-5f);
                    const float xv = (q & 1) ? hi16(v[q >> 1]) : lo16(v[q >> 1]);
                    y[q] = (xv - mean) * rstd * lg + lb;
                }
                u32x4 o;
                o[0] = pack2(y[0], y[1]); o[1] = pack2(y[2], y[3]); o[2] = pack2(y[4], y[5]); o[3] = pack2(y[6], y[7]);
                *(u32x4*)vp = o;
            }
        }
        GSYNC;
        {
            GA g = ga_make(WSB, 128, VT, 128, 128, 256, 128);
            g.nbatch = 1024; g.bdiv = 8; g.a_o = 0; g.a_i = 16384; g.b_o = 2048 * 128; g.b_i = 256 * 128;
            const float* bsp = p.gmlp_b_s;
            auto e = [=](EPI_SIG) {
                const int cn = bt >> 3, gi = bt & 7;
                EPI_FOR {
                    EPI_RC
                    const float bb = bsp[gi * 128 + row];
                    bf16_t* up = Ub + (size_t)(cn * 128 + row) * 2048 + gi * 256 + col;
                    const uint2 uv = *(const uint2*)up;
                    f32x4 o;
                    o[0] = (acc[i][j][0] + bb) * lo16(uv.x); o[1] = (acc[i][j][1] + bb) * hi16(uv.x);
                    o[2] = (acc[i][j][2] + bb) * lo16(uv.y); o[3] = (acc[i][j][3] + bb) * hi16(uv.y);
                    *(uint2*)up = pack4(o);
                }
            };
            gemm_phase(g, e, smem);
        }
        GSYNC;
        {
            GA g = ga_make(Ub, 2048, WTM + 4096 * 1024, 2048, TOK, 1024, 2048);
            EpiResid e{PRE, p.out, MOD + 2 * 12288 + 2048};
            gemm_phase(g, e, smem);
        }
        GSYNC;
        mixer_ln(p, 2, PRE);
        GSYNC;

    }
    ffn_layer(p, 2, p.out, xb, smem, false);
    {
        bf16_t* Qb = (bf16_t*)SCR;
        bf16_t* Kb = (bf16_t*)(SCR + 32 * MIB);
        bf16_t* VT = (bf16_t*)(SCR + 64 * MIB);
        bf16_t* OA = (bf16_t*)(SCR + 96 * MIB);
        {
            GA g = ga_make(XM, 1024, WTM, 1024, TOK, 1024, 1024);
            EpiStore<0> e{Qb, 1024, 0.125f};
            gemm_phase(g, e, smem);
            GA gk = ga_make(XM, 1024, WTM + 1024 * 1024, 1024, TOK, 1024, 1024);
            EpiStore<0> e2{Kb, 1024, 1.f};
            gemm_phase(gk, e2, smem);
            GA gv = ga_make(XM, 1024, WTM + 2048 * 1024, 1024, TOK, 1024, 1024);
            auto ev = [=](EPI_SIG) {
                EPI_FOR {
                    EPI_RC
                    const int pos = row & (SEQ - 1), b = row >> 13;
                    bf16_t* vp = VT + ((size_t)(b * 16) * 64 + col) * SEQ + pos;
#pragma unroll
                    for (int e = 0; e < 4; ++e) vp[(size_t)e * SEQ] = f2bf(acc[i][j][e]);
                }
            };
            gemm_phase(gv, ev, smem);
        }
        GSYNC;
#ifndef NO_SB
        {
            LOCAL_TID
            bf16_t* KS = (bf16_t*)smem;
            bf16_t* VS = KS + 64 * 72;
            float* red = (float*)(smem + 2 * 64 * 72 * 2);
            const int fr = lane & 15, fq = lane >> 4;
            for (int rep = 0; rep < REP_SB; ++rep)
            for (int t = blockIdx.x; t < 2048; t += gridDim.x) {
                const int qb = 63 - (t & 63), bh = t >> 6, b = bh >> 4, hd = bh & 15;
                const int q0 = qb * 128 + wv * 32;
                bf16x8 qf[2][2];
#pragma unroll
                for (int ni = 0; ni < 2; ++ni)
#pragma unroll
                    for (int kk = 0; kk < 2; ++kk)
                        qf[ni][kk] = *(const bf16x8*)(Qb + (size_t)(b * SEQ + q0 + ni * 16 + fr) * 1024 + hd * 64 + kk * 32 + fq * 8);
                f32x4 oacc[4][2];
#pragma unroll
                for (int di = 0; di < 4; ++di) { oacc[di][0] = (f32x4){0.f, 0.f, 0.f, 0.f}; oacc[di][1] = oacc[di][0]; }
                float R[2] = {0.f, 0.f};
                for (int kb = qb * 2 + 1; kb >= 0; --kb) {
                    __syncthreads();
#pragma unroll
                    for (int i = 0; i < 2; ++i) {
                        const int id = tid + i * 256, r = id >> 3, kc = (id & 7) * 8;
                        *(uint4*)(KS + r * 72 + kc) = *(const uint4*)(Kb + (size_t)(b * SEQ + kb * 64 + r) * 1024 + hd * 64 + kc);
                        *(uint4*)(VS + r * 72 + kc) = *(const uint4*)(VT + ((size_t)(b * 16 + hd) * 64 + r) * SEQ + kb * 64 + kc);
                    }
                    __syncthreads();
                    f32x4 st[4][2];
#pragma unroll
                    for (int mi = 0; mi < 4; ++mi) { st[mi][0] = (f32x4){0.f, 0.f, 0.f, 0.f}; st[mi][1] = st[mi][0]; }
#pragma unroll
                    for (int kk = 0; kk < 2; ++kk)
#pragma unroll
                        for (int mi = 0; mi < 4; ++mi) {
                            const bf16x8 a = *(const bf16x8*)(KS + (mi * 16 + fr) * 72 + kk * 32 + fq * 8);
                            st[mi][0] = mfma16(a, qf[0][kk], st[mi][0]);
                            st[mi][1] = mfma16(a, qf[1][kk], st[mi][1]);
                        }
#pragma unroll
                    for (int ni = 0; ni < 2; ++ni) {
                        const int qpos = q0 + ni * 16 + fr;
                        float l1[4][4], tot[4];
#pragma unroll
                        for (int mi = 0; mi < 4; ++mi) {
                            tot[mi] = 0.f;
#pragma unroll
                            for (int e = 0; e < 4; ++e) {
                                const int key = kb * 64 + mi * 16 + fq * 4 + e;
                                const float z = st[mi][ni][e];
                                const float sp = fmaxf(z, 0.f) + __logf(1.f + __expf(-fabsf(z)));
                                const bool valid = key < qpos;
                                l1[mi][e] = valid ? -sp : 0.f;
                                st[mi][ni][e] = valid ? (z - sp) : -1e30f;
                                tot[mi] += l1[mi][e];
                            }
                        }
                        float run = R[ni];
                        float blk = 0.f;
#pragma unroll
                        for (int mi = 3; mi >= 0; --mi) {
                            const float t1 = __shfl_xor(tot[mi], 16), t2 = __shfl_xor(tot[mi], 32), t3 = __shfl_xor(tot[mi], 48);
                            float hi = 0.f;
                            hi += ((fq ^ 1) > fq) ? t1 : 0.f;
                            hi += ((fq ^ 2) > fq) ? t2 : 0.f;
                            hi += ((fq ^ 3) > fq) ? t3 : 0.f;
                            float after = run + hi;
#pragma unroll
                            for (int e = 3; e >= 0; --e) {
                                st[mi][ni][e] = __expf(st[mi][ni][e] + after);
                                after += l1[mi][e];
                            }
                            const float all = tot[mi] + t1 + t2 + t3;
                            run += all;
                            blk += all;
                        }
                        R[ni] += blk;
                    }
#pragma unroll
                    for (int m2 = 0; m2 < 2; ++m2) {
                        bf16x8 pf[2];
#pragma unroll
                        for (int ni = 0; ni < 2; ++ni) {
                            const uint2 lo = pack4(st[2 * m2][ni]), hi = pack4(st[2 * m2 + 1][ni]);
                            const uint4 u = make_uint4(lo.x, lo.y, hi.x, hi.y);
                            pf[ni] = *(const bf16x8*)&u;
                        }
#pragma unroll
                        for (int di = 0; di < 4; ++di) {
                            const uint2 va = *(const uint2*)(VS + (di * 16 + fr) * 72 + (2 * m2) * 16 + fq * 4);
                            const uint2 vb = *(const uint2*)(VS + (di * 16 + fr) * 72 + (2 * m2 + 1) * 16 + fq * 4);
                            const uint4 u = make_uint4(va.x, va.y, vb.x, vb.y);
                            const bf16x8 vf = *(const bf16x8*)&u;
                            oacc[di][0] = mfma16(vf, pf[0], oacc[di][0]);
                            oacc[di][1] = mfma16(vf, pf[1], oacc[di][1]);
                        }
                    }
                    const float wm_ = wmax(fmaxf(R[0], R[1]));
                    if (lane == 0) red[wv] = wm_;
                    __syncthreads();
                    const float mx = fmaxf(fmaxf(red[0], red[1]), fmaxf(red[2], red[3]));
                    if (mx < -120.f) break;
                }
#pragma unroll
                for (int di = 0; di < 4; ++di)
#pragma unroll
                    for (int ni = 0; ni < 2; ++ni)
                        *(uint2*)(OA + (size_t)(b * SEQ + q0 + ni * 16 + fr) * 1024 + hd * 64 + di * 16 + fq * 4) = pack4(oacc[di][ni]);
            }
        }
#endif
        GSYNC;
        {
            GA g = ga_make(OA, 1024, WTM + 3072 * 1024, 1024, TOK, 1024, 1024);
            EpiResid e{PRE, p.out, MOD + 3 * 12288 + 2048};
            gemm_phase(g, e, smem);
        }
        GSYNC;
        mixer_ln(p, 3, PRE);
        GSYNC;
    }
    ffn_layer(p, 3, p.out, xb, smem, true);
}

extern "C" void kernel_launch(void* const* d_in, const int* in_sizes, int n_in, void* d_out, int out_size, void* d_ws, size_t ws_size,
                              hipStream_t stream) {
    static int grid_blocks = 0;
    if (!grid_blocks) {
        int dev = 0, cus = 0, per_cu = 0;
        hipGetDevice(&dev);
        hipDeviceGetAttribute(&cus, hipDeviceAttributeMultiprocessorCount, dev);
        hipOccupancyMaxActiveBlocksPerMultiprocessor(&per_cu, mega, 256, 0);
        if (per_cu > 2) per_cu = 2;
        grid_blocks = cus * per_cu;
    }
    if (ws_size < WS_NEED) { fprintf(stderr, "workspace too small: %zu < %zu\n", ws_size, (size_t)WS_NEED); return; }
    P p{};
    const float** pp = (const float**)&p;
    for (int i = 0; i < 28; ++i) pp[i] = (const float*)d_in[i];
    p.out = (float*)d_out;
    p.ws = (char*)d_ws;
    hipMemsetAsync((char*)d_ws + OFF_BAR, 0, XCD_BAR_WORDS * sizeof(unsigned), stream);
    void* args[] = {&p};
    hipError_t e = hipLaunchCooperativeKernel((void*)mega, dim3(grid_blocks), dim3(256), args, 0, stream);
    if (e != hipSuccess) fprintf(stderr, "cooperative launch failed: %s (grid %d)\n", hipGetErrorString(e), grid_blocks);
}
```

```cpp
#include <hip/hip_runtime.h>
#include <hip/hip_cooperative_groups.h>
#include <cstdio>
#include <cstdint>
namespace cg = cooperative_groups;

typedef unsigned short bf16_t;
typedef short bf16x8 __attribute__((ext_vector_type(8)));
typedef float f32x4 __attribute__((ext_vector_type(4)));
typedef unsigned u32x4 __attribute__((ext_vector_type(4)));

#define MIB (1024ull * 1024ull)
#ifndef REP_SYNC
#define REP_SYNC 1
#endif
#ifndef REP_F2
#define REP_F2 1
#endif
#ifndef REP_P0
#define REP_P0 1
#endif
#ifndef REP_GB
#define REP_GB 1
#endif
#ifndef REP_GD
#define REP_GD 1
#endif
#ifndef REP_SB
#define REP_SB 1
#endif
#ifndef REP_GLN
#define REP_GLN 1
#endif
#ifndef REP_LN
#define REP_LN 1
#endif
#ifndef REP_CONV
#define REP_CONV 1
#endif
#define GSYNC do { for (int r_ = 0; r_ < REP_SYNC; ++r_) xcd_barrier(xb); } while (0)
#ifndef F1_DUMMY
#define F1_DUMMY 0
#endif
#ifndef GEMM_BIG
#define GEMM_BIG gemm256
#endif
#ifndef REP_E
#define REP_E 1
#endif
#ifndef REP_F1
#define REP_F1 1
#endif
constexpr size_t OFF_WTMIX = 0;
constexpr size_t OFF_WTFFN = 16 * MIB;
constexpr size_t OFF_SMALL = 33 * MIB;
constexpr size_t OFF_COS = 34 * MIB;
constexpr size_t OFF_SIN = 38 * MIB;
constexpr size_t OFF_PRE = 42 * MIB;
constexpr size_t OFF_XM = 106 * MIB;
constexpr size_t OFF_SCR = 138 * MIB;
constexpr size_t WS_NEED = 378 * MIB;


#define XB_TMO      128
#define XB_XCNT(j)  (256  + 64 * (j))
#define XB_XSUB(j)  (1280 + 64 * (j))
#define XB_XGEN(j)  (2304 + 64 * (j))
#define XB_TOP      3328
#define XB_TOPGEN   3392
#define XCD_BAR_WORDS 3456
#define XB_SPIN_CAP (1u << 20)
#define LAS __attribute__((address_space(3)))
__device__ __forceinline__ unsigned xb_ld(unsigned* p) { return __hip_atomic_load(p, __ATOMIC_RELAXED, __HIP_MEMORY_SCOPE_AGENT); }
__device__ __forceinline__ unsigned xb_add(unsigned* p, unsigned v) { return __hip_atomic_fetch_add(p, v, __ATOMIC_RELAXED, __HIP_MEMORY_SCOPE_AGENT); }
__device__ __forceinline__ unsigned xb_xcc_id() { return (unsigned)__builtin_amdgcn_s_getreg((3 << 11) | 20) & 0xFu; }
#define XB_SPIN(cond, bar) do { unsigned _sp = 0; while (cond) { __builtin_amdgcn_s_sleep(1); \
    if ((++_sp & 255u) == 0u) { if (xb_ld(&(bar)[XB_TMO])) break; if (_sp > XB_SPIN_CAP) { atomicAdd(&(bar)[XB_TMO], 1u); break; } } } } while (0)
struct XcdBarrier { unsigned* bar; unsigned x; volatile LAS unsigned* st; };
__device__ __forceinline__ XcdBarrier xcd_barrier_post(unsigned* bar, volatile LAS unsigned* st) {
    XcdBarrier b; b.bar = bar; b.x = xb_xcc_id(); b.st = st;
    if (threadIdx.x == 0) (void)xb_add(&bar[XB_XCNT(b.x)], 1u);
    return b;
}
__device__ __forceinline__ void xcd_barrier_complete(unsigned* bar, unsigned x, unsigned& nloc, unsigned& nx) {
    const unsigned G = gridDim.x * gridDim.y * gridDim.z;
    unsigned sum, cnt, mine, sp = 0u;
    for (;;) {
        sum = 0u; cnt = 0u; mine = 0u;
#pragma unroll
        for (unsigned j = 0; j < 16; ++j) { const unsigned c = xb_ld(&bar[XB_XCNT(j)]); sum += c; cnt += (c > 0u) ? 1u : 0u; mine = (j == x) ? c : mine; }
        if (sum == G) break;
        __builtin_amdgcn_s_sleep(1);
        if ((++sp & 255u) == 0u) { if (xb_ld(&bar[XB_TMO])) break; if (sp > XB_SPIN_CAP) { atomicAdd(&bar[XB_TMO], 1u); break; } }
    }
    nloc = mine > 0u ? mine : 1u; nx = cnt > 0u ? cnt : 1u;
}
__device__ __forceinline__ void xcd_barrier(const XcdBarrier& b) {
    asm volatile("s_waitcnt vmcnt(0)" ::: "memory");
    __syncthreads();
    if (threadIdx.x == 0) {
        unsigned* bar = b.bar;
        __builtin_amdgcn_s_waitcnt(0);
        unsigned nloc = b.st[0], nx = b.st[1];
        if (nloc == 0u) { xcd_barrier_complete(bar, b.x, nloc, nx); b.st[0] = nloc; b.st[1] = nx; }
        const unsigned old = xb_add(&bar[XB_XSUB(b.x)], 1u);
        const unsigned gen = old / nloc;
        if (old + 1u == (gen + 1u) * nloc) {
            __builtin_amdgcn_fence(__ATOMIC_RELEASE, "agent");
            asm volatile("s_waitcnt vmcnt(0)" ::: "memory");
            const unsigned og = xb_add(&bar[XB_TOP], 1u);
            const unsigned tg = og / nx;
            if (og + 1u == (tg + 1u) * nx) xb_add(&bar[XB_TOPGEN], 1u);
            else XB_SPIN(xb_ld(&bar[XB_TOPGEN]) == tg, bar);
            __builtin_amdgcn_fence(__ATOMIC_ACQUIRE, "agent");
            xb_add(&bar[XB_XGEN(b.x)], 1u);
            asm volatile("s_waitcnt vmcnt(0)" ::: "memory");
        } else {
            XB_SPIN(xb_ld(&bar[XB_XGEN(b.x)]) == gen, bar);
            __builtin_amdgcn_fence(__ATOMIC_ACQUIRE, "agent");
            asm volatile("s_waitcnt vmcnt(0)" ::: "memory");
        }
    }
    __syncthreads();
}
constexpr size_t OFF_BAR = 33 * MIB + 768 * 1024;
constexpr size_t OFF_STATS = 33 * MIB + 832 * 1024;

#define LOCAL_TID                                   \
    int tid = threadIdx.x;                          \
    asm volatile("" : "+v"(tid));                   \
    const int lane = tid & 63;                      \
    const int wv = __builtin_amdgcn_readfirstlane(tid >> 6); \
    (void)lane; (void)wv;

constexpr int TOK = 16384;
constexpr int SEQ = 8192;
constexpr float DN_ALPHA = 1.681792830507429f;

struct P {
    const float *x, *c, *cond_w, *cond_b, *ada_w, *ada_b, *ln_g, *ln_b, *ffn_up, *ffn_conv_w, *ffn_conv_b, *ffn_down;
    const float *gdn_w_in, *gdn_conv_w, *gdn_a_log, *gdn_dt_bias, *gdn_norm_w, *gdn_w_out, *ret_w_in, *ret_w_out;
    const float *gmlp_w_in, *gmlp_ln_g, *gmlp_ln_b, *gmlp_w_s, *gmlp_b_s, *gmlp_w_out, *sb_w_in, *sb_w_out;
    float* out;
    char* ws;
};

__device__ __forceinline__ float bf2f(bf16_t v) { return __uint_as_float(((unsigned)v) << 16); }
__device__ __forceinline__ bf16_t f2bf(float f) {
    unsigned u = __float_as_uint(f);
    u += 0x7fffu + ((u >> 16) & 1u);
    return (bf16_t)(u >> 16);
}
__device__ __forceinline__ unsigned pack2(float a, float b) { return (unsigned)f2bf(a) | ((unsigned)f2bf(b) << 16); }
__device__ __forceinline__ uint2 pack4(f32x4 v) { uint2 r; r.x = pack2(v[0], v[1]); r.y = pack2(v[2], v[3]); return r; }
__device__ __forceinline__ float lo16(unsigned u) { return __uint_as_float(u << 16); }
__device__ __forceinline__ float hi16(unsigned u) { return __uint_as_float(u & 0xffff0000u); }
__device__ __forceinline__ float wsum(float v) {
#pragma unroll
    for (int o = 32; o > 0; o >>= 1) v += __shfl_xor(v, o);
    return v;
}
__device__ __forceinline__ float wmax(float v) {
#pragma unroll
    for (int o = 32; o > 0; o >>= 1) v = fmaxf(v, __shfl_xor(v, o));
    return v;
}
__device__ __forceinline__ float silu_f(float x) { return x / (1.f + __expf(-x)); }
__device__ __forceinline__ float sigmoid_f(float x) { return 1.f / (1.f + __expf(-x)); }
__device__ __forceinline__ float gelu_f(float v) {
    const float av = fabsf(v), d = av * 0.2316418882f + 1.0f;
    const float t = __builtin_amdgcn_rcpf(d);
    float q = t * 0.5307027145f + (-0.7265760135f);
    q = q * t + 0.7107068705f; q = q * t + (-0.142248368f); q = q * t + 0.127414796f; q = q * t;
    const float e = __builtin_amdgcn_exp2f((v * v) * (-0.72134752044f));
    const float m = v * (q * e);
    return v < 0.f ? m : v - m;
}
__device__ __forceinline__ float softplus_f(float x) { return fmaxf(x, 0.f) + log1pf(__expf(-fabsf(x))); }
__device__ __forceinline__ f32x4 mfma16(bf16x8 a, bf16x8 b, f32x4 c) { return __builtin_amdgcn_mfma_f32_16x16x32_bf16(a, b, c, 0, 0, 0); }

__device__ __forceinline__ int ret_perm(int n) {
    if (n >= 2048) return n;
    int hb = n & ~255, pl = n & 255, kq = pl >> 5, e = pl & 31;
    return hb + (e < 16 ? 16 * kq + e : 128 + 16 * kq + (e - 16));
}
__device__ __forceinline__ int ffn_perm(int n) {
    const int ch = (n >> 7) * 64 + ((n >> 6) & 1) * 32 + (n & 31);
    return (n & 32) ? 2816 + ch : ch;
}
__device__ __forceinline__ void conv_job(const float* __restrict__ src, int K, int N, bf16_t* __restrict__ dst, int Np, int mode, char* smem) {
    float* lds = (float*)smem;
    int tid = threadIdx.x;
    asm volatile("" : "+v"(tid));
    const int ntn = Np >> 6, nkt = K >> 6, total = ntn * nkt;
    for (int rep = 0; rep < REP_CONV; ++rep)
    for (int t = blockIdx.x; t < total; t += gridDim.x) {
        const int nt = t % ntn, kt = t / ntn, n0 = nt * 64, k0 = kt * 64;
        __syncthreads();
        {
            const int n = tid & 63, ng = n0 + n;
            const int sc = (mode == 1) ? ret_perm(ng) : (mode == 2) ? ffn_perm(ng) : ng;
            const bool ok = sc < N;
#pragma unroll
            for (int i = 0; i < 16; ++i) {
                const int k = i * 4 + (tid >> 6);
                lds[k * 65 + n] = ok ? src[(size_t)(k0 + k) * N + sc] : 0.f;
            }
        }
        __syncthreads();
        {
#pragma unroll
            for (int i = 0; i < 2; ++i) {
                const int id = tid + i * 256, n = id >> 3, k8 = (id & 7) * 8;
                u32x4 o;
                o[0] = pack2(lds[(k8 + 0) * 65 + n], lds[(k8 + 1) * 65 + n]);
                o[1] = pack2(lds[(k8 + 2) * 65 + n], lds[(k8 + 3) * 65 + n]);
                o[2] = pack2(lds[(k8 + 4) * 65 + n], lds[(k8 + 5) * 65 + n]);
                o[3] = pack2(lds[(k8 + 6) * 65 + n], lds[(k8 + 7) * 65 + n]);
                *(u32x4*)(dst + (size_t)(n0 + n) * K + k0 + k8) = o;
            }
        }
    }
}

__device__ __forceinline__ void convert_layer(const P& p, int l, char* smem) {
    bf16_t* WTM = (bf16_t*)(p.ws + OFF_WTMIX);
    bf16_t* WTF = (bf16_t*)(p.ws + OFF_WTFFN);
    const float* win = l == 0 ? p.gdn_w_in : l == 1 ? p.ret_w_in : l == 2 ? p.gmlp_w_in : p.sb_w_in;
    const float* wout = l == 0 ? p.gdn_w_out : l == 1 ? p.ret_w_out : l == 2 ? p.gmlp_w_out : p.sb_w_out;
    const int nin = l == 0 ? 4112 : l == 1 ? 6144 : l == 2 ? 4096 : 3072;
    const int npin = l == 0 ? 4224 : nin;
    const int kout = (l == 1 || l == 2) ? 2048 : 1024;
    conv_job(win, 1024, nin, WTM, npin, l == 1 ? 1 : 0, smem);
    conv_job(wout, kout, 1024, WTM + (size_t)npin * 1024, 1024, 0, smem);
    conv_job(p.ffn_up + (size_t)l * 1024 * 5632, 1024, 5632, WTF, 5632, 2, smem);
    conv_job(p.ffn_down + (size_t)l * 2816 * 1024, 2816, 1024, WTF + 5632 * 1024, 1024, 0, smem);
}

struct GA {
    const bf16_t *A, *B, *A2, *B2;
    long lda, ldb, lda2, ldb2;
    long a_o, a_i, b_o, b_i, a2_o, a2_i, b2_o, b2_i;
    int bdiv, M, N, K, K2, nbatch;
};
__device__ __forceinline__ GA ga_make(const bf16_t* A, long lda, const bf16_t* B, long ldb, int M, int N, int K) {
    GA g;
    g.A = A; g.B = B; g.A2 = A; g.B2 = B; g.lda = lda; g.ldb = ldb; g.lda2 = lda; g.ldb2 = ldb;
    g.a_o = g.a_i = g.b_o = g.b_i = g.a2_o = g.a2_i = g.b2_o = g.b2_i = 0;
    g.bdiv = 1; g.M = M; g.N = N; g.K = K; g.K2 = 0; g.nbatch = 1;
    return g;
}

template <int GBK, class Epi, int MODE = 0>
__device__ __forceinline__ void gemm_phase_t(const GA& g, Epi epi, char* smem) {
    constexpr int LDT = GBK + 8, GNCH = GBK / 8, GRPP = 256 / GNCH, GNLD = 128 / GRPP;
    int tid = threadIdx.x;
    asm volatile("" : "+v"(tid));
    const int lane = tid & 63, w = __builtin_amdgcn_readfirstlane(tid >> 6), wm = w >> 1, wn = w & 1;
    const int tm = g.M >> 7, tn = g.N >> 7, per = tm * tn, total = per * g.nbatch;
    const int nk1 = g.K / GBK, nk = nk1 + g.K2 / GBK;
    const int fr = lane & 15, fq = lane >> 4;
    char* const lw = smem + ((tid / GNCH) * LDT + (tid % GNCH) * 8) * 2;
    const char* const lra = smem + ((wm * 64 + fr) * LDT + fq * 8) * 2;
    const char* const lrb = smem + 128 * LDT * 2 + ((wn * 64 + fr) * LDT + fq * 8) * 2;
    const unsigned oa1 = ((unsigned)(tid / GNCH) * (unsigned)g.lda + (tid % GNCH) * 8) * 2u;
    const unsigned ob1 = ((unsigned)(tid / GNCH) * (unsigned)g.ldb + (tid % GNCH) * 8) * 2u;
    const size_t sa1 = (size_t)(2 * GRPP) * (size_t)g.lda, sb1 = (size_t)(2 * GRPP) * (size_t)g.ldb;
    u32x4 ra[GNLD], rb[GNLD];
    bool pre = false;
#define GPT_TILE(tt, SFX)                                                                                     \
    const int bt##SFX = (tt) / per, idx##SFX = (tt) - bt##SFX * per;                                           \
    const int grp##SFX = idx##SFX / (8 * tn), rem##SFX = idx##SFX - grp##SFX * 8 * tn;                         \
    const int gsz##SFX = (tm - grp##SFX * 8) < 8 ? (tm - grp##SFX * 8) : 8;                                    \
    const int pm##SFX = grp##SFX * 8 + rem##SFX % gsz##SFX, pn##SFX = rem##SFX / gsz##SFX;                     \
    const int bo##SFX = bt##SFX / g.bdiv, bi##SFX = bt##SFX - bo##SFX * g.bdiv;                                \
    const bf16_t* Ab##SFX = g.A + bo##SFX * g.a_o + bi##SFX * g.a_i + (long)(pm##SFX * 128) * g.lda;           \
    const bf16_t* Bb##SFX = g.B + bo##SFX * g.b_o + bi##SFX * g.b_i + (long)(pn##SFX * 128) * g.ldb;
    for (int t = blockIdx.x; t < total; t += gridDim.x) {
        GPT_TILE(t, )
        const bf16_t* A2b = g.A2 + bo * g.a2_o + bi * g.a2_i + (long)(pm * 128) * g.lda2;
        const bf16_t* B2b = g.B2 + bo * g.b2_o + bi * g.b2_i + (long)(pn * 128) * g.ldb2;
        f32x4 acc[4][4];
#pragma unroll
        for (int i = 0; i < 4; ++i)
#pragma unroll
            for (int j = 0; j < 4; ++j) acc[i][j] = (f32x4){0.f, 0.f, 0.f, 0.f};
        if (!pre) {
#pragma unroll
            for (int i = 0; i < GNLD; ++i) {
                ra[i] = *(const u32x4*)(((const char*)Ab + i * sa1) + (size_t)oa1);
                rb[i] = *(const u32x4*)(((const char*)Bb + i * sb1) + (size_t)ob1);
            }
        }
        for (int kt = 0; kt < nk; ++kt) {
            __syncthreads();
#pragma unroll
            for (int i = 0; i < GNLD; ++i) {
                *(u32x4*)(lw + i * (GRPP * LDT * 2)) = ra[i];
                *(u32x4*)(lw + 128 * LDT * 2 + i * (GRPP * LDT * 2)) = rb[i];
            }
            __syncthreads();
            if (kt + 1 < nk) {
                const int kn = kt + 1;
                const char* pa; const char* pb; unsigned la, lb;
                if (kn < nk1) { pa = (const char*)(Ab + kn * GBK); pb = (const char*)(Bb + kn * GBK); la = (unsigned)g.lda; lb = (unsigned)g.ldb; }
                else { pa = (const char*)(A2b + (kn - nk1) * GBK); pb = (const char*)(B2b + (kn - nk1) * GBK); la = (unsigned)g.lda2; lb = (unsigned)g.ldb2; }
                const unsigned oa = ((unsigned)(tid / GNCH) * la + (tid % GNCH) * 8) * 2u;
                const unsigned ob = ((unsigned)(tid / GNCH) * lb + (tid % GNCH) * 8) * 2u;
                const size_t sa = (size_t)(2 * GRPP) * (size_t)la, sb = (size_t)(2 * GRPP) * (size_t)lb;
#pragma unroll
                for (int i = 0; i < GNLD; ++i) {
                    ra[i] = *(const u32x4*)((pa + i * sa) + (size_t)oa);
                    rb[i] = *(const u32x4*)((pb + i * sb) + (size_t)ob);
                }
            } else {
                const int t2 = t + gridDim.x;
                pre = t2 < total;
                if (pre) {
                    GPT_TILE(t2, _n)
#pragma unroll
                    for (int i = 0; i < GNLD; ++i) {
                        ra[i] = *(const u32x4*)(((const char*)Ab_n + i * sa1) + (size_t)oa1);
                        rb[i] = *(const u32x4*)(((const char*)Bb_n + i * sb1) + (size_t)ob1);
                    }
                }
            }
#pragma unroll
            for (int kk = 0; kk < GBK / 32; ++kk) {
                bf16x8 a[4];
#pragma unroll
                for (int i = 0; i < 4; ++i) a[i] = *(const bf16x8*)(lra + (i * 16 * LDT + kk * 32) * 2);
#pragma unroll
                for (int j = 0; j < 4; ++j) {
                    const bf16x8 b = *(const bf16x8*)(lrb + (j * 16 * LDT + kk * 32) * 2);
#pragma unroll
                    for (int i = 0; i < 4; ++i) acc[i][j] = mfma16(b, a[i], acc[i][j]);
                }
            }
        }
        epi(bt, pm * 128 + wm * 64, pn * 128 + wn * 64, acc, lane);
    }
#undef GPT_TILE
}
template <class Epi>
__device__ __forceinline__ void gemm256(const GA& g, Epi epi, char* smem) {
    constexpr int LDT = 72;
    int tid = threadIdx.x;
    asm volatile("" : "+v"(tid));
    const int lane = tid & 63, w = __builtin_amdgcn_readfirstlane(tid >> 6), wm = w >> 1, wn = w & 1;
    const int tm = g.M >> 8, tn = g.N >> 7, per = tm * tn, total = per * g.nbatch;
    const int nk = g.K >> 6;
    const int fr = lane & 15, fq = lane >> 4;
    char* const lw = smem + ((tid >> 3) * LDT + (tid & 7) * 8) * 2;
    const char* const lra = smem + ((wm * 128 + fr) * LDT + fq * 8) * 2;
    const char* const lrb = smem + 256 * LDT * 2 + ((wn * 64 + fr) * LDT + fq * 8) * 2;
    for (int t = blockIdx.x; t < total; t += gridDim.x) {
        const int bt = t / per, idx = t - bt * per;
        const int grp = idx / (8 * tn), rem = idx - grp * 8 * tn;
        const int gsz = (tm - grp * 8) < 8 ? (tm - grp * 8) : 8;
        const int pm = grp * 8 + rem % gsz, pn = rem / gsz;
        const int bo = bt / g.bdiv, bi = bt - bo * g.bdiv;
        const char* Ab = (const char*)(g.A + bo * g.a_o + bi * g.a_i + (long)(pm * 256) * g.lda);
        const char* Bb = (const char*)(g.B + bo * g.b_o + bi * g.b_i + (long)(pn * 128) * g.ldb);
        f32x4 acc[2][4][4];
#pragma unroll
        for (int h = 0; h < 2; ++h)
#pragma unroll
            for (int i = 0; i < 4; ++i)
#pragma unroll
                for (int j = 0; j < 4; ++j) acc[h][i][j] = (f32x4){0.f, 0.f, 0.f, 0.f};
        u32x4 ra[8], rb[4];
        const unsigned oa = ((unsigned)(tid >> 3) * (unsigned)g.lda + (tid & 7) * 8) * 2u;
        const unsigned ob = ((unsigned)(tid >> 3) * (unsigned)g.ldb + (tid & 7) * 8) * 2u;
        const size_t sa = (size_t)64 * (size_t)g.lda, sb = (size_t)64 * (size_t)g.ldb;
#pragma unroll
        for (int i = 0; i < 8; ++i) ra[i] = *(const u32x4*)((Ab + i * sa) + (size_t)oa);
#pragma unroll
        for (int i = 0; i < 4; ++i) rb[i] = *(const u32x4*)((Bb + i * sb) + (size_t)ob);
        for (int kt = 0; kt < nk; ++kt) {
            __syncthreads();
#pragma unroll
            for (int i = 0; i < 8; ++i) *(u32x4*)(lw + i * (32 * LDT * 2)) = ra[i];
#pragma unroll
            for (int i = 0; i < 4; ++i) *(u32x4*)(lw + 256 * LDT * 2 + i * (32 * LDT * 2)) = rb[i];
            __syncthreads();
            if (kt + 1 < nk) {
                const char* pa = Ab + (size_t)(kt + 1) * 128;
                const char* pb = Bb + (size_t)(kt + 1) * 128;
#pragma unroll
                for (int i = 0; i < 8; ++i) ra[i] = *(const u32x4*)((pa + i * sa) + (size_t)oa);
#pragma unroll
                for (int i = 0; i < 4; ++i) rb[i] = *(const u32x4*)((pb + i * sb) + (size_t)ob);
            }
#pragma unroll
            for (int kk = 0; kk < 2; ++kk) {
                bf16x8 b[4];
#pragma unroll
                for (int j = 0; j < 4; ++j) b[j] = *(const bf16x8*)(lrb + (j * 16 * LDT + kk * 32) * 2);
#pragma unroll
                for (int h = 0; h < 2; ++h) {
                    bf16x8 a[4];
#pragma unroll
                    for (int i = 0; i < 4; ++i) a[i] = *(const bf16x8*)(lra + ((h * 4 + i) * 16 * LDT + kk * 32) * 2);
#pragma unroll
                    for (int j = 0; j < 4; ++j)
#pragma unroll
                        for (int i = 0; i < 4; ++i) acc[h][i][j] = mfma16(b[j], a[i], acc[h][i][j]);
                }
            }
        }
        epi(bt, pm * 256 + wm * 128, pn * 128 + wn * 64, acc[0], lane);
        epi(bt, pm * 256 + wm * 128 + 64, pn * 128 + wn * 64, acc[1], lane);
    }
}
#ifndef GBKD
#define GBKD 128
#endif
template <class Epi>
__device__ __forceinline__ void gemm_phase(const GA& g, Epi epi, char* smem) {
    if (g.nbatch <= 2 && (g.M & 255) == 0 && g.K2 == 0) gemm256(g, epi, smem);
    else gemm_phase_t<GBKD>(g, epi, smem);
}

#define EPI_SIG int bt, int row0, int col0, f32x4(&acc)[4][4], int lane
#define EPI_FOR                                   \
    _Pragma("unroll") for (int i = 0; i < 4; ++i) \
        _Pragma("unroll") for (int j = 0; j < 4; ++j)
#define EPI_RC                                  \
    if (j == 0) asm volatile("" ::: "memory");   \
    const int row = row0 + i * 16 + (lane & 15); \
    const int col = col0 + j * 16 + (lane >> 4) * 4;

__device__ __forceinline__ void ln_phase(const float* __restrict__ pre, const float* __restrict__ g, const float* __restrict__ bta,
                         float* __restrict__ xout, bf16_t* __restrict__ xm, const float* __restrict__ modn, int sh_off, int sc_off) {
    int tidl = threadIdx.x;
    asm volatile("" : "+v"(tidl));
    const int lane = tidl & 63, w = tidl >> 6;
    for (int r = blockIdx.x * 4 + w; r < SEQ; r += gridDim.x * 4) {
        f32x4 v[2][4];
        float s[2] = {0.f, 0.f};
#pragma unroll
        for (int h = 0; h < 2; ++h)
#pragma unroll
            for (int i = 0; i < 4; ++i) {
                v[h][i] = *(const f32x4*)(pre + (size_t)(r + h * SEQ) * 1024 + (i * 64 + lane) * 4);
                s[h] += (v[h][i][0] + v[h][i][1]) + (v[h][i][2] + v[h][i][3]);
            }
#pragma unroll
        for (int o = 32; o > 0; o >>= 1) { s[0] += __shfl_xor(s[0], o); s[1] += __shfl_xor(s[1], o); }
        float q[2] = {0.f, 0.f};
#pragma unroll
        for (int h = 0; h < 2; ++h) {
            const float mean = s[h] * (1.f / 1024.f);
#pragma unroll
            for (int i = 0; i < 4; ++i) {
                v[h][i] = v[h][i] - mean;
                q[h] += (v[h][i][0] * v[h][i][0] + v[h][i][1] * v[h][i][1]) + (v[h][i][2] * v[h][i][2] + v[h][i][3] * v[h][i][3]);
            }
        }
#pragma unroll
        for (int o = 32; o > 0; o >>= 1) { q[0] += __shfl_xor(q[0], o); q[1] += __shfl_xor(q[1], o); }
#pragma unroll
        for (int i = 0; i < 4; ++i) {
            const int c = (i * 64 + lane) * 4;
            const f32x4 gg = *(const f32x4*)(g + c), bb = *(const f32x4*)(bta + c);
#pragma unroll
            for (int h = 0; h < 2; ++h) {
                const float rstd = rsqrtf(q[h] * (1.f / 1024.f) + 1e-5f);
                const f32x4 y = v[h][i] * rstd * gg + bb;
                *(f32x4*)(xout + (size_t)(r + h * SEQ) * 1024 + c) = y;
                if (xm) {
                    const f32x4 sc = *(const f32x4*)(modn + h * 6144 + sc_off + c), sh = *(const f32x4*)(modn + h * 6144 + sh_off + c);
                    const f32x4 ym = y * (sc + 1.f) + sh;
                    *(uint2*)(xm + (size_t)(r + h * SEQ) * 1024 + c) = pack4(ym);
                }
            }
        }
    }
}

struct EpiResid {
    float* pre; const float* x; const float* gate;
    __device__ __forceinline__ void operator()(EPI_SIG) const {
        EPI_FOR {
            EPI_RC
            const int tok = bt * SEQ + row;
            const int b = tok >> 13;
            const float4 xv = *(const float4*)(x + (size_t)tok * 1024 + col);
            const float4 gv = *(const float4*)(gate + b * 6144 + col);
            float4 o;
            o.x = DN_ALPHA * xv.x + (1.f + gv.x) * acc[i][j][0];
            o.y = DN_ALPHA * xv.y + (1.f + gv.y) * acc[i][j][1];
            o.z = DN_ALPHA * xv.z + (1.f + gv.z) * acc[i][j][2];
            o.w = DN_ALPHA * xv.w + (1.f + gv.w) * acc[i][j][3];
            *(float4*)(pre + (size_t)tok * 1024 + col) = o;
        }
    }
};
template <int ACT>
struct EpiStore {
    bf16_t* O; long ldo; float scale;
    __device__ __forceinline__ void operator()(EPI_SIG) const {
        EPI_FOR {
            EPI_RC
            f32x4 v = acc[i][j];
            if (ACT == 1) { v[0] = gelu_f(v[0]); v[1] = gelu_f(v[1]); v[2] = gelu_f(v[2]); v[3] = gelu_f(v[3]); }
            v = v * scale;
            *(uint2*)(O + (size_t)row * ldo + col) = pack4(v);
        }
    }
};

__device__ __forceinline__ void ffn_layer(const P& p, int l, const float* xres, const XcdBarrier& xb, char* smem, bool last) {
    bf16_t* WTF = (bf16_t*)(p.ws + OFF_WTFFN);
    float* MOD = (float*)(p.ws + OFF_SMALL) + 4096;
    bf16_t* XM = (bf16_t*)(p.ws + OFF_XM);
    bf16_t* ACT = (bf16_t*)(p.ws + OFF_SCR);
    float* HG = (float*)(p.ws + OFF_SCR + 96 * MIB);
    float* HU = (float*)(p.ws + OFF_SCR + 108 * MIB);
    float* PRE2 = (float*)(p.ws + OFF_PRE);
    const float* cw = p.ffn_conv_w + (size_t)l * 3 * 2816;
    const float* cb = p.ffn_conv_b + (size_t)l * 2816;
    {
        GA g = ga_make(XM, 1024, WTF, 1024, TOK, 5632, 1024);
        auto e = [=](EPI_SIG) {
            const int fr = lane & 15, fq = lane >> 4;
            const int cb0 = (col0 >> 1) + fq * 4;
            const int grp = row0 >> 6;
#pragma unroll
            for (int j = 0; j < 2; ++j) {
                const int c = cb0 + j * 16;
                const f32x4 w0a = *(const f32x4*)(cw + c), w1a = *(const f32x4*)(cw + 2816 + c), w2a = *(const f32x4*)(cw + 5632 + c), bba = *(const f32x4*)(cb + c);
#pragma unroll
                for (int i = 0; i < 4; ++i) {
                    const int tok = row0 + i * 16 + fr;
                    f32x4 o;
#pragma unroll
                    for (int e4 = 0; e4 < 4; ++e4) {
                        const float gcur = acc[i][j][e4];
                        const float gprv = (i > 0) ? acc[i > 0 ? i - 1 : 0][j][e4] : 0.f;
                        const float c1 = __int_as_float(__builtin_amdgcn_update_dpp(0, __float_as_int(gcur), 0x121, 0xf, 0xf, false));
                        const float c2 = __int_as_float(__builtin_amdgcn_update_dpp(0, __float_as_int(gcur), 0x122, 0xf, 0xf, false));
                        const float q1 = __int_as_float(__builtin_amdgcn_update_dpp(0, __float_as_int(gprv), 0x121, 0xf, 0xf, false));
                        const float q2 = __int_as_float(__builtin_amdgcn_update_dpp(0, __float_as_int(gprv), 0x122, 0xf, 0xf, false));
                        const float p1 = (fr >= 1) ? c1 : q1, p2 = (fr >= 2) ? c2 : q2;
                        const float y = w2a[e4] * gcur + w1a[e4] * p1 + w0a[e4] * p2 + bba[e4];
                        o[e4] = silu_f(y) * acc[i][j + 2][e4];
                    }
                    if (i > 0 || fr >= 2) *(uint2*)(ACT + (size_t)tok * 2816 + c) = pack4(o);
                    if (i == 0 && fr < 2) {
                        *(float4*)(HG + ((size_t)grp * 4 + 2 + fr) * 2816 + c) = make_float4(acc[0][j][0], acc[0][j][1], acc[0][j][2], acc[0][j][3]);
                        *(float4*)(HU + ((size_t)grp * 2 + fr) * 2816 + c) = make_float4(acc[0][j + 2][0], acc[0][j + 2][1], acc[0][j + 2][2], acc[0][j + 2][3]);
                    }
                    if (i == 3 && fr >= 14)
                        *(float4*)(HG + ((size_t)grp * 4 + (fr - 14)) * 2816 + c) = make_float4(acc[3][j][0], acc[3][j][1], acc[3][j][2], acc[3][j][3]);
                }
            }
        };
        GEMM_BIG(g, e, smem);
    }
    GSYNC;
    {
        int tidl = threadIdx.x;
        asm volatile("" : "+v"(tidl));
        for (int it = blockIdx.x * 256 + tidl; it < 256 * 2 * 704; it += gridDim.x * 256) {
            const int c = (it % 704) * 4, gr = it / 704, r = gr & 1, grp = gr >> 1;
            const int tok = grp * 64 + r, ts = tok & (SEQ - 1);
            const f32x4 z4 = (f32x4){0.f, 0.f, 0.f, 0.f};
            const f32x4 g0 = *(const f32x4*)(HG + ((size_t)grp * 4 + 2 + r) * 2816 + c);
            const int gp = grp > 0 ? grp - 1 : 0;
            const f32x4 h62 = *(const f32x4*)(HG + ((size_t)gp * 4 + 0) * 2816 + c);
            const f32x4 h63 = *(const f32x4*)(HG + ((size_t)gp * 4 + 1) * 2816 + c);
            const f32x4 h0 = *(const f32x4*)(HG + ((size_t)grp * 4 + 2) * 2816 + c);
            const f32x4 p1 = (r == 0) ? ((ts >= 1) ? h63 : z4) : h0;
            const f32x4 p2 = (r == 0) ? ((ts >= 2) ? h62 : z4) : ((ts >= 2) ? h63 : z4);
            const f32x4 up = *(const f32x4*)(HU + ((size_t)grp * 2 + r) * 2816 + c);
            const f32x4 w0 = *(const f32x4*)(cw + c), w1 = *(const f32x4*)(cw + 2816 + c), w2 = *(const f32x4*)(cw + 5632 + c), bb = *(const f32x4*)(cb + c);
            f32x4 o;
#pragma unroll
            for (int q = 0; q < 4; ++q) o[q] = silu_f(w2[q] * g0[q] + w1[q] * p1[q] + w0[q] * p2[q] + bb[q]) * up[q];
            *(uint2*)(ACT + (size_t)tok * 2816 + c) = pack4(o);
        }
    }
    GSYNC;
    {
        GA g = ga_make(ACT, 2816, WTF + 5632 * 1024, 2816, TOK, 1024, 2816);
        EpiResid e{PRE2, xres, MOD + l * 12288 + 5120};
        GEMM_BIG(g, e, smem);
    }
    GSYNC;
    {
        const float* modn = MOD + (l + 1) * 12288;
        ln_phase(PRE2, p.ln_g + (l * 2 + 1) * 1024, p.ln_b + (l * 2 + 1) * 1024, p.out, last ? nullptr : XM, modn, 0, 1024);
        if (!last) convert_layer(p, l + 1, smem);
    }
    GSYNC;
}

__device__ __forceinline__ void mixer_ln(const P& p, int l, const float* pre) {
    float* MOD = (float*)(p.ws + OFF_SMALL) + 4096;
    bf16_t* XM = (bf16_t*)(p.ws + OFF_XM);
    ln_phase(pre, p.ln_g + (l * 2) * 1024, p.ln_b + (l * 2) * 1024, p.out, XM, MOD + l * 12288, 3072, 4096);
}

template <int C>
struct SolveRow {
    static __device__ __forceinline__ void run(float (&sol)[64], const float* kks, const bf16_t* srcp, const float* bs, const float* gcs, bool isv) {
        float a = sol[C] * bs[C];
        if (!isv) a *= __expf(gcs[C]);
        float a1 = 0.f, a2 = 0.f, a3 = 0.f;
#pragma unroll
        for (int m = 0; m < C; ++m) {
            const float pr = kks[C * 64 + m] * sol[m];
            if ((m & 3) == 0) a -= pr; else if ((m & 3) == 1) a1 -= pr; else if ((m & 3) == 2) a2 -= pr; else a3 -= pr;
        }
        a = (a + a1) + (a2 + a3);
        asm volatile("" : "+v"(a) : : "memory");
        sol[C] = a;
        SolveRow<C + 1>::run(sol, kks, srcp, bs, gcs, isv);
    }
};
template <>
struct SolveRow<64> {
    static __device__ __forceinline__ void run(float (&)[64], const float*, const bf16_t*, const float*, const float*, bool) {}
};

extern "C" __global__ void __launch_bounds__(256, 2) mega(P p) {
    cg::grid_group grid = cg::this_grid();
    __shared__ __attribute__((aligned(16))) char smem[73728];
    __shared__ uint4 xb_words;
    const int tid = threadIdx.x, lane = tid & 63, wv = tid >> 6;
    if (tid == 0) xb_words = make_uint4(0u, 0u, 0u, 0u);
    __syncthreads();
    const XcdBarrier xb = xcd_barrier_post((unsigned*)(p.ws + OFF_BAR), (volatile LAS unsigned*)&xb_words);
    bf16_t* WTM = (bf16_t*)(p.ws + OFF_WTMIX);
    float* EV = (float*)(p.ws + OFF_SMALL);
    float* MOD = (float*)(p.ws + OFF_SMALL) + 4096;
    bf16_t* WSB = (bf16_t*)(p.ws + OFF_SMALL + 512 * 1024);
    float* COS = (float*)(p.ws + OFF_COS);
    float* SIN = (float*)(p.ws + OFF_SIN);
    float* PRE = (float*)(p.ws + OFF_PRE);
    bf16_t* XM = (bf16_t*)(p.ws + OFF_XM);
    char* SCR = p.ws + OFF_SCR;

    convert_layer(p, 0, smem);
    {
        float* red = (float*)smem;
        for (int rep = 0; rep < REP_P0; ++rep)
        for (int t = blockIdx.x; t < 64; t += gridDim.x) {
            const int col = t * 16 + (tid & 15), ks = tid >> 4;
            float a0 = 0.f, a1 = 0.f;
#pragma unroll 8
            for (int k = ks * 64; k < ks * 64 + 64; ++k) {
                const float wv_ = p.cond_w[(size_t)k * 1024 + col];
                a0 += p.c[k] * wv_;
                a1 += p.c[1024 + k] * wv_;
            }
            __syncthreads();
            red[tid * 2] = a0; red[tid * 2 + 1] = a1;
            __syncthreads();
            if (tid < 32) {
                const int c = tid & 15, b = tid >> 4;
                float sm = 0.f;
                for (int q = 0; q < 16; ++q) sm += red[(q * 16 + c) * 2 + b];
                const int cc = t * 16 + c;
                EV[b * 1024 + cc] = silu_f(sm + p.cond_b[cc]);
            }
        }
    }
    for (int rep = 0; rep < REP_P0; ++rep)
    for (int it = blockIdx.x * 256 + tid; it < SEQ * 128; it += gridDim.x * 256) {
        const int pos = it >> 7, i = it & 127;
        double f = 1.0;
        const double r = 0.9300449458481391823675;
        for (int q = 0; q < i; ++q) f *= r;
        double rev = (double)pos * f * 0.1591549430918953357689;
        rev -= floor(rev);
        const float fr = (float)rev;
        COS[it] = __builtin_amdgcn_cosf(fr);
        SIN[it] = __builtin_amdgcn_sinf(fr);
    }
    for (int it = blockIdx.x * 256 + tid; it < TOK * 2; it += gridDim.x * 256) ((float*)(p.ws + OFF_STATS))[it] = 0.f;
    for (int it = blockIdx.x * 256 + tid; it < 8 * 128 * 128; it += gridDim.x * 256) {
        const int s = it & 127, t = (it >> 7) & 127;
        WSB[it] = (s <= t) ? f2bf(p.gmlp_w_s[it]) : (bf16_t)0;
    }
    if (p.ws == nullptr) grid.sync();
    GSYNC;
    {
        float* red = (float*)smem;
        for (int rep = 0; rep < REP_P0; ++rep)
        for (int t = blockIdx.x; t < 1536; t += gridDim.x) {
            const int l = t / 384, cgp = t - l * 384;
            const int col = cgp * 16 + (tid & 15), ks = tid >> 4;
            const float* wp = p.ada_w + (size_t)l * 1024 * 6144 + col;
            float a0 = 0.f, a1 = 0.f;
#pragma unroll 8
            for (int k = ks * 64; k < ks * 64 + 64; ++k) {
                const float wv_ = wp[(size_t)k * 6144];
                a0 += EV[k] * wv_;
                a1 += EV[1024 + k] * wv_;
            }
            __syncthreads();
            red[tid * 2] = a0; red[tid * 2 + 1] = a1;
            __syncthreads();
            if (tid < 32) {
                const int c = tid & 15, b = tid >> 4;
                float sm = 0.f;
                for (int q = 0; q < 16; ++q) sm += red[(q * 16 + c) * 2 + b];
                const int cc = cgp * 16 + c;
                MOD[l * 12288 + b * 6144 + cc] = sm + p.ada_b[l * 6144 + cc];
            }
        }
    }
    GSYNC;
    { LOCAL_TID
    for (int it = blockIdx.x * 256 + tid; it < TOK * 256; it += gridDim.x * 256) {
        const int tok = it >> 8, c = (it & 255) * 4, b = tok >> 13;
        const float4 xv = *(const float4*)(p.x + (size_t)tok * 1024 + c);
        const float4 sh = *(const float4*)(MOD + b * 6144 + c), sc = *(const float4*)(MOD + b * 6144 + 1024 + c);
        uint2 o;
        o.x = pack2(xv.x * (1.f + sc.x) + sh.x, xv.y * (1.f + sc.y) + sh.y);
        o.y = pack2(xv.z * (1.f + sc.z) + sh.z, xv.w * (1.f + sc.w) + sh.w);
        *(uint2*)(XM + (size_t)tok * 1024 + c) = o;
    }
    }
    GSYNC;

    {
        bf16_t* QKV = (bf16_t*)SCR;
        bf16_t* Z = (bf16_t*)(SCR + 96 * MIB);
        float* AB = (float*)(SCR + 128 * MIB);
        float* BETA = (float*)(SCR + 129 * MIB);
        float* GC = (float*)(SCR + 130 * MIB);
        float* KK = (float*)(SCR + 131 * MIB);
        bf16_t* QKb = (bf16_t*)(SCR + 163 * MIB);
        bf16_t* Qn = (bf16_t*)(p.ws + OFF_PRE);
        bf16_t* Kn = (bf16_t*)(p.ws + OFF_PRE + 32 * MIB);
        bf16_t* Vc = XM;
        bf16_t* U = (bf16_t*)SCR;
        bf16_t* W = (bf16_t*)(SCR + 32 * MIB);
        bf16_t* KDT = (bf16_t*)(SCR + 64 * MIB);
        bf16_t* O = XM;
        {
            GA g = ga_make(XM, 1024, WTM, 1024, TOK, 3072, 1024);
            EpiStore<0> e{QKV, 3072, 1.f};
            gemm_phase(g, e, smem);
            GA g2 = ga_make(XM, 1024, WTM + 3072 * 1024, 1024, TOK, 1024, 1024);
            EpiStore<0> e2{Z, 1024, 1.f};
            gemm_phase(g2, e2, smem);
            GA g3 = ga_make(XM, 1024, WTM + 4096 * 1024, 1024, TOK, 128, 1024);
            auto e3 = [=](EPI_SIG) {
#pragma unroll
                for (int i = 0; i < 4; ++i) {
                    const int row = row0 + i * 16 + (lane & 15);
                    const int col = col0 + (lane >> 4) * 4;
                    if (col0 == 0) *(float4*)(AB + (size_t)row * 16 + col) = make_float4(acc[i][0][0], acc[i][0][1], acc[i][0][2], acc[i][0][3]);
                }
            };
            gemm_phase(g3, e3, smem);
        }
        GSYNC;
        {
            LOCAL_TID
            float* gs = (float*)smem;
            for (int rep = 0; rep < REP_GB; ++rep)
            for (int t = blockIdx.x; t < 1536; t += gridDim.x) {
                const int ct = t / 6, sg = t - ct * 6;
                const int tokw = ct * 64 + wv * 16;
                const int ts = tokw & (SEQ - 1);
                for (int s4 = 0; s4 < 4; ++s4) {
                    const int seg = sg * 4 + s4;
                    const int ch = seg * 128 + lane * 2;
                    const float2 w0 = *(const float2*)(p.gdn_conv_w + ch), w1 = *(const float2*)(p.gdn_conv_w + 3072 + ch),
                                 w2 = *(const float2*)(p.gdn_conv_w + 2 * 3072 + ch), w3 = *(const float2*)(p.gdn_conv_w + 3 * 3072 + ch);
                    unsigned x0 = 0, x1 = 0, x2 = 0;
                    if (ts >= 3) {
                        x0 = *(const unsigned*)(QKV + (size_t)(tokw - 3) * 3072 + ch);
                        x1 = *(const unsigned*)(QKV + (size_t)(tokw - 2) * 3072 + ch);
                        x2 = *(const unsigned*)(QKV + (size_t)(tokw - 1) * 3072 + ch);
                    }
                    unsigned xr[16];
#pragma unroll
                    for (int i = 0; i < 16; ++i) xr[i] = *(const unsigned*)(QKV + (size_t)(tokw + i) * 3072 + ch);
                    float y0[16], y1[16], ss[16];
#pragma unroll
                    for (int i = 0; i < 16; ++i) {
                        const unsigned x3 = xr[i];
                        y0[i] = silu_f(w3.x * lo16(x3) + w2.x * lo16(x2) + w1.x * lo16(x1) + w0.x * lo16(x0));
                        y1[i] = silu_f(w3.y * hi16(x3) + w2.y * hi16(x2) + w1.y * hi16(x1) + w0.y * hi16(x0));
                        x0 = x1; x1 = x2; x2 = x3;
                        ss[i] = y0[i] * y0[i] + y1[i] * y1[i];
                    }
                    if (seg < 16) {
#pragma unroll
                        for (int o = 32; o > 0; o >>= 1)
#pragma unroll
                            for (int i = 0; i < 16; ++i) ss[i] += __shfl_xor(ss[i], o);
                        const float qs = (seg < 8) ? 0.08838834764831845f : 1.f;
#pragma unroll
                        for (int i = 0; i < 16; ++i) {
                            const float r = rsqrtf(ss[i] + 1e-6f) * qs;
                            y0[i] *= r; y1[i] *= r;
                        }
                    }
                    bf16_t* dst = (seg < 8) ? (Qn + (size_t)tokw * 1024 + ch) : (seg < 16) ? (Kn + (size_t)tokw * 1024 + (ch - 1024)) : (Vc + (size_t)tokw * 1024 + (ch - 2048));
#pragma unroll
                    for (int i = 0; i < 16; ++i) *(unsigned*)(dst + (size_t)i * 1024) = pack2(y0[i], y1[i]);
                }
                if (sg == 0) {
                    __syncthreads();
                    if (lane < 8) {
                        const float al = __expf(p.gdn_a_log[lane]), dtb = p.gdn_dt_bias[lane];
                        for (int i = 0; i < 16; ++i) {
                            const int tok = tokw + i;
                            const float a = AB[(size_t)tok * 16 + lane], btv = AB[(size_t)tok * 16 + 8 + lane];
                            BETA[(size_t)tok * 8 + lane] = sigmoid_f(btv);
                            gs[(wv * 16 + i) * 8 + lane] = -al * softplus_f(a + dtb);
                        }
                    }
                    __syncthreads();
                    if (tid < 8) {
                        float run = 0.f;
                        for (int i = 0; i < 64; ++i) {
                            run += gs[i * 8 + tid];
                            GC[(size_t)(ct * 64 + i) * 8 + tid] = run;
                        }
                    }
                }
            }
        }
        GSYNC;
        {
            GA g = ga_make(Kn, 1024, Kn, 1024, 128, 128, 128);
            g.nbatch = 128 * 8; g.bdiv = 8; g.a_o = 131072; g.a_i = 128; g.b_o = 131072; g.b_i = 128;
            auto ekk = [=](EPI_SIG) {
                const int bo = bt >> 3, h = bt & 7;
                EPI_FOR {
                    EPI_RC
                    if ((row >> 6) == (col >> 6)) {
                        const int tokr = bo * 128 + row;
                        const float gr = GC[(size_t)tokr * 8 + h], br = BETA[(size_t)tokr * 8 + h];
                        float o[4];
#pragma unroll
                        for (int e = 0; e < 4; ++e) {
                            const int cc = col + e;
                            const float gcv = GC[(size_t)(bo * 128 + cc) * 8 + h];
                            o[e] = (cc < row) ? acc[i][j][e] * br * __expf(gr - gcv) : 0.f;
                        }
                        *(float4*)(KK + ((size_t)tokr * 8 + h) * 64 + (col & 63)) = make_float4(o[0], o[1], o[2], o[3]);
                    }
                }
            };
            gemm_phase(g, ekk, smem);
            GA g2 = g; g2.A = Qn; g2.A2 = Qn;
            auto eqk = [=](EPI_SIG) {
                const int bo = bt >> 3, h = bt & 7;
                EPI_FOR {
                    EPI_RC
                    if ((row >> 6) == (col >> 6)) {
                        const int tokr = bo * 128 + row;
                        const float gr = GC[(size_t)tokr * 8 + h];
                        f32x4 o;
#pragma unroll
                        for (int e = 0; e < 4; ++e) {
                            const int cc = col + e;
                            const float gcv = GC[(size_t)(bo * 128 + cc) * 8 + h];
                            o[e] = (cc <= row) ? acc[i][j][e] * __expf(gr - gcv) : 0.f;
                        }
                        *(uint2*)(QKb + ((size_t)tokr * 8 + h) * 64 + (col & 63)) = pack4(o);
                    }
                }
            };
            gemm_phase(g2, eqk, smem);
        }
        GSYNC;
#ifndef NO_D
        {
            LOCAL_TID
            float* kks = (float*)smem;
            bf16_t* kdl = (bf16_t*)(smem + 16384);
            float* bs = (float*)(smem + 16384 + 17408);
            float* gcs = bs + 64;
            for (int rep = 0; rep < REP_GD; ++rep)
            for (int t = blockIdx.x; t < 2048; t += gridDim.x) {
                const int cn = t >> 3, h = t & 7, tok0 = cn * 64;
                __syncthreads();
#pragma unroll
                for (int i = 0; i < 16; ++i) {
                    const int idx = tid + i * 256, c = idx >> 6, m = idx & 63;
                    kks[idx] = KK[((size_t)(tok0 + c) * 8 + h) * 64 + m];
                }
                if (tid < 64) { bs[tid] = BETA[(size_t)(tok0 + tid) * 8 + h]; gcs[tid] = GC[(size_t)(tok0 + tid) * 8 + h]; }
                __syncthreads();
                const bool isv = tid < 128;
                const bf16_t* srcp = isv ? (Vc + (size_t)tok0 * 1024 + h * 128 + tid) : (Kn + (size_t)tok0 * 1024 + h * 128 + (tid - 128));
                float sol[64];
#pragma unroll
                for (int c = 0; c < 64; ++c) sol[c] = bf2f(srcp[(size_t)c * 1024]);
                SolveRow<0>::run(sol, kks, srcp, bs, gcs, isv);
                bf16_t* dstp = isv ? (U + (size_t)tok0 * 1024 + h * 128 + tid) : (W + (size_t)tok0 * 1024 + h * 128 + (tid - 128));
#pragma unroll
                for (int c = 0; c < 64; ++c) dstp[(size_t)c * 1024] = f2bf(sol[c]);
                {
                    const int dk = tid & 127, half = tid >> 7;
                    const float gl = gcs[63];
                    for (int c = half * 32; c < half * 32 + 32; ++c)
                        kdl[c * 136 + dk] = f2bf(bf2f(Kn[(size_t)(tok0 + c) * 1024 + h * 128 + dk]) * __expf(gl - gcs[c]));
                }
                __syncthreads();
                {
                    const int dk = tid >> 1, hf = tid & 1;
                    bf16_t* dp = KDT + ((size_t)(cn * 8 + h) * 128 + dk) * 64 + hf * 32;
#pragma unroll
                    for (int c8 = 0; c8 < 4; ++c8) {
                        unsigned u4[4];
#pragma unroll
                        for (int q = 0; q < 4; ++q) {
                            const int c = hf * 32 + c8 * 8 + q * 2;
                            u4[q] = (unsigned)kdl[c * 136 + dk] | ((unsigned)kdl[(c + 1) * 136 + dk] << 16);
                        }
                        *(uint4*)(dp + c8 * 8) = make_uint4(u4[0], u4[1], u4[2], u4[3]);
                    }
                }
            }
        }
#endif
        GSYNC;
#ifndef NO_E
        {
            LOCAL_TID
            bf16_t* ST = (bf16_t*)smem;
            bf16_t* WC = ST + 16 * 136;
            bf16_t* QC = WC + 64 * 136;
            bf16_t* QKC = QC + 64 * 136;
            bf16_t* KDS = QKC + 64 * 72;
            bf16_t* VNT = KDS + 128 * 72;
            const int fr = lane & 15, fq = lane >> 4;
            for (int rep = 0; rep < REP_E; ++rep)
            for (int t = blockIdx.x; t < 128; t += gridDim.x) {
                const int b = t >> 6, h = (t >> 3) & 7, sl = t & 7;
                const int dv0 = h * 128 + sl * 16;
                f32x4 sacc[2];
                sacc[0] = (f32x4){0.f, 0.f, 0.f, 0.f}; sacc[1] = sacc[0];
                __syncthreads();
                for (int i = tid; i < 16 * 136; i += 256) ST[i] = 0;
                u32x4 pw[4], pq[4], pqk[2], pkd[4];
                float pu[4], pgc[4], pgl;
#define SCAN_ISSUE(nn)                                                                                                   \
    {                                                                                                                    \
        const int cn_ = b * 128 + (nn), tk_ = cn_ * 64;                                                                  \
        _Pragma("unroll") for (int i = 0; i < 4; ++i) {                                                                  \
            const int id = tid + i * 256, r = id >> 4, kc = (id & 15) * 8;                                               \
            pw[i] = *(const u32x4*)(W + (size_t)(tk_ + r) * 1024 + h * 128 + kc);                                        \
            pq[i] = *(const u32x4*)(Qn + (size_t)(tk_ + r) * 1024 + h * 128 + kc);                                       \
        }                                                                                                                \
        _Pragma("unroll") for (int i = 0; i < 2; ++i) {                                                                  \
            const int id = tid + i * 256, r = id >> 3, kc = (id & 7) * 8;                                                \
            pqk[i] = *(const u32x4*)(QKb + ((size_t)(tk_ + r) * 8 + h) * 64 + kc);                                       \
        }                                                                                                                \
        _Pragma("unroll") for (int i = 0; i < 4; ++i) {                                                                  \
            const int id = tid + i * 256, r = id >> 3, kc = (id & 7) * 8;                                                \
            pkd[i] = *(const u32x4*)(KDT + ((size_t)(cn_ * 8 + h) * 128 + r) * 64 + kc);                                \
        }                                                                                                                \
        _Pragma("unroll") for (int e = 0; e < 4; ++e) {                                                                  \
            const int tok = tk_ + wv * 16 + fq * 4 + e;                                                                  \
            pu[e] = bf2f(U[(size_t)tok * 1024 + dv0 + fr]);                                                              \
            pgc[e] = GC[(size_t)tok * 8 + h];                                                                            \
        }                                                                                                                \
        pgl = GC[(size_t)(tk_ + 63) * 8 + h];                                                                            \
    }
                SCAN_ISSUE(0)
                for (int n = 0; n < 128; ++n) {
                    const int cn = b * 128 + n, tok0 = cn * 64;
                    __syncthreads();
#pragma unroll
                    for (int i = 0; i < 4; ++i) {
                        const int id = tid + i * 256, r = id >> 4, kc = (id & 15) * 8;
                        *(u32x4*)(WC + r * 136 + kc) = pw[i];
                        *(u32x4*)(QC + r * 136 + kc) = pq[i];
                    }
#pragma unroll
                    for (int i = 0; i < 2; ++i) {
                        const int id = tid + i * 256, r = id >> 3, kc = (id & 7) * 8;
                        *(u32x4*)(QKC + r * 72 + kc) = pqk[i];
                    }
#pragma unroll
                    for (int i = 0; i < 4; ++i) {
                        const int id = tid + i * 256, r = id >> 3, kc = (id & 7) * 8;
                        *(u32x4*)(KDS + r * 72 + kc) = pkd[i];
                    }
                    float ucur[4], gcr[4];
#pragma unroll
                    for (int e = 0; e < 4; ++e) { ucur[e] = pu[e]; gcr[e] = pgc[e]; }
                    const float glc = pgl;
                    __syncthreads();
                    if (n + 1 < 128) SCAN_ISSUE(n + 1)
                    const int c0 = wv * 16;
                    f32x4 wsv = (f32x4){0.f, 0.f, 0.f, 0.f}, o1 = wsv;
#pragma unroll
                    for (int kk = 0; kk < 4; ++kk) {
                        const bf16x8 a = *(const bf16x8*)(WC + (c0 + fr) * 136 + kk * 32 + fq * 8);
                        const bf16x8 q = *(const bf16x8*)(QC + (c0 + fr) * 136 + kk * 32 + fq * 8);
                        const bf16x8 s = *(const bf16x8*)(ST + fr * 136 + kk * 32 + fq * 8);
                        wsv = mfma16(a, s, wsv);
                        o1 = mfma16(q, s, o1);
                    }
                    f32x4 vn;
#pragma unroll
                    for (int e = 0; e < 4; ++e) vn[e] = ucur[e] - wsv[e];
                    *(uint2*)(VNT + fr * 72 + c0 + fq * 4) = pack4(vn);
                    __syncthreads();
                    f32x4 o2 = (f32x4){0.f, 0.f, 0.f, 0.f};
#pragma unroll
                    for (int kk = 0; kk < 2; ++kk) {
                        const bf16x8 a = *(const bf16x8*)(QKC + (c0 + fr) * 72 + kk * 32 + fq * 8);
                        const bf16x8 v = *(const bf16x8*)(VNT + fr * 72 + kk * 32 + fq * 8);
                        o2 = mfma16(a, v, o2);
                    }
#pragma unroll
                    for (int e = 0; e < 4; ++e) {
                        const int tok = tok0 + c0 + fq * 4 + e;
                        O[(size_t)tok * 1024 + dv0 + fr] = f2bf(o1[e] * __expf(gcr[e]) + o2[e]);
                    }
                    const float eg = __expf(glc);
#pragma unroll
                    for (int tt = 0; tt < 2; ++tt) {
                        const int mt = wv * 2 + tt;
                        f32x4 d = (f32x4){0.f, 0.f, 0.f, 0.f};
#pragma unroll
                        for (int kk = 0; kk < 2; ++kk) {
                            const bf16x8 a = *(const bf16x8*)(KDS + (mt * 16 + fr) * 72 + kk * 32 + fq * 8);
                            const bf16x8 v = *(const bf16x8*)(VNT + fr * 72 + kk * 32 + fq * 8);
                            d = mfma16(a, v, d);
                        }
                        sacc[tt] = sacc[tt] * eg + d;
                        *(uint2*)(ST + fr * 136 + mt * 16 + fq * 4) = pack4(sacc[tt]);
                    }
                }
            }
        }
#endif
        GSYNC;
        { LOCAL_TID
        for (int tok = blockIdx.x * 4 + wv; tok < TOK; tok += gridDim.x * 4) {
            unsigned ov[8], zv[8];
            float ss[8];
#pragma unroll
            for (int h = 0; h < 8; ++h) {
                ov[h] = *(const unsigned*)(O + (size_t)tok * 1024 + h * 128 + lane * 2);
                zv[h] = *(const unsigned*)(Z + (size_t)tok * 1024 + h * 128 + lane * 2);
                ss[h] = lo16(ov[h]) * lo16(ov[h]) + hi16(ov[h]) * hi16(ov[h]);
            }
#pragma unroll
            for (int o = 32; o > 0; o >>= 1)
#pragma unroll
                for (int h = 0; h < 8; ++h) ss[h] += __shfl_xor(ss[h], o);
            const float2 nw = *(const float2*)(p.gdn_norm_w + lane * 2);
#pragma unroll
            for (int h = 0; h < 8; ++h) {
                const float r = rsqrtf(ss[h] * (1.f / 128.f) + 1e-6f);
                *(unsigned*)(O + (size_t)tok * 1024 + h * 128 + lane * 2) =
                    pack2(lo16(ov[h]) * r * nw.x * silu_f(lo16(zv[h])), hi16(ov[h]) * r * nw.y * silu_f(hi16(zv[h])));
            }
        }
        }
        GSYNC;
        {
            GA g = ga_make(O, 1024, WTM + 4224 * 1024, 1024, TOK, 1024, 1024);
            EpiResid e{PRE, p.x, MOD + 0 * 12288 + 2048};
            gemm_phase(g, e, smem);
        }
        GSYNC;
        mixer_ln(p, 0, PRE);
        GSYNC;

    }
    ffn_layer(p, 0, p.out, xb, smem, false);
    {
        bf16_t* QX = (bf16_t*)SCR;
        bf16_t* KZT = (bf16_t*)(SCR + 32 * MIB);
        bf16_t* VT = (bf16_t*)(SCR + 64 * MIB);
        bf16_t* GATE = (bf16_t*)(SCR + 128 * MIB);
        bf16_t* Kr = (bf16_t*)(SCR + 192 * MIB);
        bf16_t* SC = (bf16_t*)(SCR + 224 * MIB);
        bf16_t* STATE = (bf16_t*)(p.ws + OFF_PRE);
        bf16_t* OR0 = XM;
        bf16_t* OR1 = Kr;
        float* PRE1 = (float*)SCR;
        float l2g[4];
#pragma unroll
        for (int h = 0; h < 4; ++h) l2g[h] = log2f(1.f - exp2f(-5.f - (float)h));
        {
            GA g = ga_make(XM, 1024, WTM, 1024, TOK, 1024, 1024);
            auto eq = [=](EPI_SIG) {
#pragma unroll
                for (int i = 0; i < 4; ++i) {
                    const int tok = row0 + i * 16 + (lane & 15);
                    const int pos = tok & (SEQ - 1), c = pos & 127;
#pragma unroll
                    for (int jp = 0; jp < 4; jp += 2) {
                        const int col = col0 + jp * 16 + (lane >> 4) * 4;
                        const int hd = col >> 8, pl = col & 255, ai = 16 * (pl >> 5) + (lane >> 4) * 4;
                        const float lg = hd == 0 ? l2g[0] : hd == 1 ? l2g[1] : hd == 2 ? l2g[2] : l2g[3];
                        const float xi = exp2f((float)(c + 1) * lg);
                        const float4 cs = *(const float4*)(COS + pos * 128 + ai), sn = *(const float4*)(SIN + pos * 128 + ai);
                        const float csa[4] = {cs.x, cs.y, cs.z, cs.w}, sna[4] = {sn.x, sn.y, sn.z, sn.w};
                        f32x4 r1, r2;
#pragma unroll
                        for (int e = 0; e < 4; ++e) {
                            const float t1 = acc[i][jp][e], t2 = acc[i][jp + 1][e];
                            r1[e] = (t1 * csa[e] - t2 * sna[e]) * xi;
                            r2[e] = (t1 * sna[e] + t2 * csa[e]) * xi;
                        }
                        *(uint2*)(QX + (size_t)tok * 1024 + col) = pack4(r1);
                        *(uint2*)(QX + (size_t)tok * 1024 + col + 16) = pack4(r2);
                    }
                }
            };
            gemm_phase(g, eq, smem);
            GA gk = ga_make(XM, 1024, WTM + 1024 * 1024, 1024, TOK, 1024, 1024);
            auto ek = [=](EPI_SIG) {
#pragma unroll
                for (int i = 0; i < 4; ++i) {
                    const int tok = row0 + i * 16 + (lane & 15);
                    const int pos = tok & (SEQ - 1), c = pos & 127, b = tok >> 13;
#pragma unroll
                    for (int jp = 0; jp < 4; jp += 2) {
                        const int col = col0 + jp * 16 + (lane >> 4) * 4;
                        const int hd = col >> 8, pl = col & 255, ai = 16 * (pl >> 5) + (lane >> 4) * 4;
                        const float lg = hd == 0 ? l2g[0] : hd == 1 ? l2g[1] : hd == 2 ? l2g[2] : l2g[3];
                        const float zeta = exp2f((float)(127 - c) * lg);
                        const float4 cs = *(const float4*)(COS + pos * 128 + ai), sn = *(const float4*)(SIN + pos * 128 + ai);
                        const float csa[4] = {cs.x, cs.y, cs.z, cs.w}, sna[4] = {sn.x, sn.y, sn.z, sn.w};
                        f32x4 r1, r2;
#pragma unroll
                        for (int e = 0; e < 4; ++e) {
                            const float t1 = acc[i][jp][e], t2 = acc[i][jp + 1][e];
                            r1[e] = (t1 * csa[e] - t2 * sna[e]) * 0.0625f;
                            r2[e] = (t1 * sna[e] + t2 * csa[e]) * 0.0625f;
                        }
                        *(uint2*)(Kr + (size_t)tok * 1024 + col) = pack4(r1);
                        *(uint2*)(Kr + (size_t)tok * 1024 + col + 16) = pack4(r2);
                        bf16_t* kz = KZT + ((size_t)(b * 4 + hd) * 256 + pl) * SEQ + pos;
#pragma unroll
                        for (int e = 0; e < 4; ++e) {
                            kz[(size_t)e * SEQ] = f2bf(r1[e] * zeta);
                            kz[(size_t)(e + 16) * SEQ] = f2bf(r2[e] * zeta);
                        }
                    }
                }
            };
            gemm_phase(gk, ek, smem);
            GA gv = ga_make(XM, 1024, WTM + 2048 * 1024, 1024, TOK, 2048, 1024);
            auto ev = [=](EPI_SIG) {
                EPI_FOR {
                    EPI_RC
                    const int pos = row & (SEQ - 1), b = row >> 13, hd = col >> 9, dv = col & 511;
                    bf16_t* vp = VT + ((size_t)(b * 4 + hd) * 512 + dv) * SEQ + pos;
#pragma unroll
                    for (int e = 0; e < 4; ++e) vp[(size_t)e * SEQ] = f2bf(acc[i][j][e]);
                }
            };
            gemm_phase(gv, ev, smem);
            GA gg = ga_make(XM, 1024, WTM + 4096 * 1024, 1024, TOK, 2048, 1024);
            EpiStore<0> eg{GATE, 2048, 1.f};
            gemm_phase(gg, eg, smem);
        }
        GSYNC;
        {
            GA g = ga_make(QX, 1024, Kr, 1024, 128, 128, 256);
            g.nbatch = 512; g.bdiv = 4; g.a_o = 131072; g.a_i = 256; g.b_o = 131072; g.b_i = 256;
            auto es = [=](EPI_SIG) {
                const int cn = bt >> 2, h = bt & 3;
                const float lg = h == 0 ? l2g[0] : h == 1 ? l2g[1] : h == 2 ? l2g[2] : l2g[3];
                EPI_FOR {
                    EPI_RC
                    f32x4 o;
#pragma unroll
                    for (int e = 0; e < 4; ++e) {
                        const int m = col + e;
                        o[e] = (m <= row) ? acc[i][j][e] * exp2f(-(float)(m + 1) * lg) : 0.f;
                    }
                    *(uint2*)(SC + ((size_t)(cn * 128 + row)) * 512 + h * 128 + col) = pack4(o);
                }
            };
            gemm_phase(g, es, smem);
        }
        for (int b = 0; b < 2; ++b) {
            {
                GA g = ga_make(VT + (size_t)b * 4 * 512 * SEQ, SEQ, KZT + (size_t)b * 4 * 256 * SEQ, SEQ, 512, 256, 128);
                g.nbatch = 256; g.bdiv = 64; g.a_o = 512 * SEQ; g.a_i = 128; g.b_o = 256 * SEQ; g.b_i = 128;
                auto e = [=](EPI_SIG) {
                    EPI_FOR {
                        EPI_RC
                        *(uint2*)(STATE + ((size_t)bt * 512 + row) * 256 + col) = pack4(acc[i][j]);
                    }
                };
                gemm_phase(g, e, smem);
            }
            GSYNC;
            {
            LOCAL_TID
                const int it = blockIdx.x * 256 + tid;
                if (it < 65536) {
                    const int h = it >> 14;
                    const float lg = h == 0 ? l2g[0] : h == 1 ? l2g[1] : h == 2 ? l2g[2] : l2g[3];
                    const float gch = exp2f(128.f * lg);
                    bf16_t* sp = STATE + (size_t)h * 64 * 131072 + (size_t)(it & 16383) * 8;
                    float st[8];
#pragma unroll
                    for (int q = 0; q < 8; ++q) st[q] = 0.f;
                    for (int n0 = 0; n0 < 64; n0 += 8) {
                        u32x4 kvb[8];
#pragma unroll
                        for (int q = 0; q < 8; ++q) kvb[q] = *(const u32x4*)(sp + (size_t)(n0 + q) * 131072);
#pragma unroll
                        for (int q = 0; q < 8; ++q) {
                            const u32x4 kv = kvb[q];
                            u32x4 o;
                            o[0] = pack2(st[0], st[1]); o[1] = pack2(st[2], st[3]); o[2] = pack2(st[4], st[5]); o[3] = pack2(st[6], st[7]);
                            *(u32x4*)(sp + (size_t)(n0 + q) * 131072) = o;
                            st[0] = st[0] * gch + lo16(kv[0]); st[1] = st[1] * gch + hi16(kv[0]);
                            st[2] = st[2] * gch + lo16(kv[1]); st[3] = st[3] * gch + hi16(kv[1]);
                            st[4] = st[4] * gch + lo16(kv[2]); st[5] = st[5] * gch + hi16(kv[2]);
                            st[6] = st[6] * gch + lo16(kv[3]); st[7] = st[7] * gch + hi16(kv[3]);
                        }
                    }
                }
            }
            GSYNC;
            {
                GA g = ga_make(QX + (size_t)b * 64 * 131072, 1024, STATE, 256, 128, 512, 256);
                g.nbatch = 256; g.bdiv = 64; g.a_o = 256; g.a_i = 131072; g.b_o = 64 * 131072; g.b_i = 131072;
                g.A2 = SC + (size_t)b * 64 * 128 * 512; g.lda2 = 512; g.a2_o = 128; g.a2_i = 128 * 512;
                g.B2 = VT + (size_t)b * 4 * 512 * SEQ; g.ldb2 = SEQ; g.b2_o = 512 * SEQ; g.b2_i = 128; g.K2 = 128;
                bf16_t* ORb = b ? OR1 : OR0;
                auto e = [=](EPI_SIG) {
                    const int h = bt >> 6, n = bt & 63;
                    EPI_FOR {
                        EPI_RC
                        *(uint2*)(ORb + ((size_t)(n * 128 + row)) * 2048 + h * 512 + col) = pack4(acc[i][j]);
                    }
                };
                gemm_phase(g, e, smem);
            }
            GSYNC;
        }
        { LOCAL_TID
        for (int tok = blockIdx.x * 4 + wv; tok < TOK; tok += gridDim.x * 4) {
            bf16_t* op = (tok >> 13) ? (OR1 + (size_t)(tok & (SEQ - 1)) * 2048) : (OR0 + (size_t)tok * 2048);
            u32x4 ov[4], gv[4];
            float sm[4], qq[4];
#pragma unroll
            for (int h = 0; h < 4; ++h) {
                ov[h] = *(const u32x4*)(op + h * 512 + lane * 8);
                gv[h] = *(const u32x4*)(GATE + (size_t)tok * 2048 + h * 512 + lane * 8);
                sm[h] = 0.f;
#pragma unroll
                for (int q = 0; q < 4; ++q) sm[h] += lo16(ov[h][q]) + hi16(ov[h][q]);
            }
#pragma unroll
            for (int o = 32; o > 0; o >>= 1)
#pragma unroll
                for (int h = 0; h < 4; ++h) sm[h] += __shfl_xor(sm[h], o);
#pragma unroll
            for (int h = 0; h < 4; ++h) {
                const float mean = sm[h] * (1.f / 512.f);
                sm[h] = mean;
                qq[h] = 0.f;
#pragma unroll
                for (int q = 0; q < 4; ++q) {
                    const float d0 = lo16(ov[h][q]) - mean, d1 = hi16(ov[h][q]) - mean;
                    qq[h] += d0 * d0 + d1 * d1;
                }
            }
#pragma unroll
            for (int o = 32; o > 0; o >>= 1)
#pragma unroll
                for (int h = 0; h < 4; ++h) qq[h] += __shfl_xor(qq[h], o);
#pragma unroll
            for (int h = 0; h < 4; ++h) {
                const float rstd = rsqrtf(qq[h] * (1.f / 512.f) + 1e-6f), mean = sm[h];
                u32x4 r;
#pragma unroll
                for (int q = 0; q < 4; ++q)
                    r[q] = pack2((lo16(ov[h][q]) - mean) * rstd * silu_f(lo16(gv[h][q])), (hi16(ov[h][q]) - mean) * rstd * silu_f(hi16(gv[h][q])));
                *(u32x4*)(op + h * 512 + lane * 8) = r;
            }
        }
        }
        GSYNC;
        {
            GA g = ga_make(OR0, 2048, WTM + 6144 * 1024, 2048, SEQ, 1024, 2048);
            g.nbatch = 2; g.bdiv = 1; g.a_o = (long)(OR1 - OR0);
            EpiResid e{PRE1, p.out, MOD + 1 * 12288 + 2048};
            gemm_phase(g, e, smem);
        }
        GSYNC;
        mixer_ln(p, 1, PRE1);
        GSYNC;

    }
    ffn_layer(p, 1, p.out, xb, smem, false);
    {
        bf16_t* Ub = (bf16_t*)SCR;
        bf16_t* VT = (bf16_t*)(SCR + 64 * MIB);
        {
            GA g = ga_make(XM, 1024, WTM, 1024, TOK, 2048, 1024);
            EpiStore<1> e{Ub, 2048, 1.f};
            gemm_phase(g, e, smem);
            GA gv = ga_make(XM, 1024, WTM + 2048 * 1024, 1024, TOK, 2048, 1024);
            float* STATS = (float*)(p.ws + OFF_STATS);
            auto ev = [=](EPI_SIG) {
#pragma unroll
                for (int i = 0; i < 4; ++i) {
                    const int row = row0 + i * 16 + (lane & 15);
                    const int cn = row >> 7, s = row & 127;
                    float sm = 0.f, sq = 0.f;
#pragma unroll
                    for (int j = 0; j < 4; ++j) {
                        const int col = col0 + j * 16 + (lane >> 4) * 4;
                        bf16_t* vp = VT + ((size_t)cn * 2048 + col) * 128 + s;
#pragma unroll
                        for (int e = 0; e < 4; ++e) {
                            const bf16_t hv = f2bf(gelu_f(acc[i][j][e]));
                            vp[(size_t)e * 128] = hv;
                            const float fv = bf2f(hv);
                            sm += fv; sq += fv * fv;
                        }
                    }
                    sm += __shfl_xor(sm, 16); sq += __shfl_xor(sq, 16);
                    sm += __shfl_xor(sm, 32); sq += __shfl_xor(sq, 32);
                    if (lane < 16) { atomicAdd(STATS + (size_t)row * 2, sm); atomicAdd(STATS + (size_t)row * 2 + 1, sq); }
                }
            };
            gemm_phase(gv, ev, smem);
        }
        GSYNC;
        {
            LOCAL_TID
            const float* STATS = (const float*)(p.ws + OFF_STATS);
            for (int it = blockIdx.x * 256 + tid; it < 128 * 2048 * 16; it += gridDim.x * 256) {
                const int s8 = it & 15, d = (it >> 4) & 2047, cn = it >> 15;
                bf16_t* vp = VT + ((size_t)cn * 2048 + d) * 128 + s8 * 8;
                const u32x4 v = *(const u32x4*)vp;
                const float* st = STATS + (size_t)(cn * 128 + s8 * 8) * 2;
                const float4 s0 = *(const float4*)st, s1 = *(const float4*)(st + 4), s2 = *(const float4*)(st + 8), s3 = *(const float4*)(st + 12);
                const float lg = p.gmlp_ln_g[d], lb = p.gmlp_ln_b[d];
                const float sums[8] = {s0.x, s0.z, s1.x, s1.z, s2.x, s2.z, s3.x, s3.z};
                const float sqs[8] = {s0.y, s0.w, s1.y, s1.w, s2.y, s2.w, s3.y, s3.w};
                float y[8];
#pragma unroll
                for (int q = 0; q < 8; ++q) {
                    const float mean = sums[q] * (1.f / 2048.f);
                    const float var = fmaxf(sqs[q] * (1.f / 2048.f) - mean * mean, 0.f);
                    const float rstd = rsqrtf(var + 1e-5f);
                    const float xv = (q & 1) ? hi16(v[q >> 1]) : lo16(v[q >> 1]);
                    y[q] = (xv - mean) * rstd * lg + lb;
                }
                u32x4 o;
                o[0] = pack2(y[0], y[1]); o[1] = pack2(y[2], y[3]); o[2] = pack2(y[4], y[5]); o[3] = pack2(y[6], y[7]);
                *(u32x4*)vp = o;
            }
        }
        GSYNC;
        {
            GA g = ga_make(WSB, 128, VT, 128, 128, 256, 128);
            g.nbatch = 1024; g.bdiv = 8; g.a_o = 0; g.a_i = 16384; g.b_o = 2048 * 128; g.b_i = 256 * 128;
            const float* bsp = p.gmlp_b_s;
            auto e = [=](EPI_SIG) {
                const int cn = bt >> 3, gi = bt & 7;
                EPI_FOR {
                    EPI_RC
                    const float bb = bsp[gi * 128 + row];
                    bf16_t* up = Ub + (size_t)(cn * 128 + row) * 2048 + gi * 256 + col;
                    const uint2 uv = *(const uint2*)up;
                    f32x4 o;
                    o[0] = (acc[i][j][0] + bb) * lo16(uv.x); o[1] = (acc[i][j][1] + bb) * hi16(uv.x);
                    o[2] = (acc[i][j][2] + bb) * lo16(uv.y); o[3] = (acc[i][j][3] + bb) * hi16(uv.y);
                    *(uint2*)up = pack4(o);
                }
            };
            gemm_phase(g, e, smem);
        }
        GSYNC;
        {
            GA g = ga_make(Ub, 2048, WTM + 4096 * 1024, 2048, TOK, 1024, 2048);
            EpiResid e{PRE, p.out, MOD + 2 * 12288 + 2048};
            gemm_phase(g, e, smem);
        }
        GSYNC;
        mixer_ln(p, 2, PRE);
        GSYNC;

    }
    ffn_layer(p, 2, p.out, xb, smem, false);
    {
        bf16_t* Qb = (bf16_t*)SCR;
        bf16_t* Kb = (bf16_t*)(SCR + 32 * MIB);
        bf16_t* VT = (bf16_t*)(SCR + 64 * MIB);
        bf16_t* OA = (bf16_t*)(SCR + 96 * MIB);
        {
            GA g = ga_make(XM, 1024, WTM, 1024, TOK, 1024, 1024);
            EpiStore<0> e{Qb, 1024, 0.125f};
            gemm_phase(g, e, smem);
            GA gk = ga_make(XM, 1024, WTM + 1024 * 1024, 1024, TOK, 1024, 1024);
            EpiStore<0> e2{Kb, 1024, 1.f};
            gemm_phase(gk, e2, smem);
            GA gv = ga_make(XM, 1024, WTM + 2048 * 1024, 1024, TOK, 1024, 1024);
            auto ev = [=](EPI_SIG) {
                EPI_FOR {
                    EPI_RC
                    const int pos = row & (SEQ - 1), b = row >> 13;
                    bf16_t* vp = VT + ((size_t)(b * 16) * 64 + col) * SEQ + pos;
#pragma unroll
                    for (int e = 0; e < 4; ++e) vp[(size_t)e * SEQ] = f2bf(acc[i][j][e]);
                }
            };
            gemm_phase(gv, ev, smem);
        }
        GSYNC;
#ifndef NO_SB
        {
            LOCAL_TID
            bf16_t* KS = (bf16_t*)smem;
            bf16_t* VS = KS + 64 * 72;
            float* red = (float*)(smem + 2 * 64 * 72 * 2);
            const int fr = lane & 15, fq = lane >> 4;
            for (int rep = 0; rep < REP_SB; ++rep)
            for (int t = blockIdx.x; t < 2048; t += gridDim.x) {
                const int qb = 63 - (t & 63), bh = t >> 6, b = bh >> 4, hd = bh & 15;
                const int q0 = qb * 128 + wv * 32;
                bf16x8 qf[2][2];
#pragma unroll
                for (int ni = 0; ni < 2; ++ni)
#pragma unroll
                    for (int kk = 0; kk < 2; ++kk)
                        qf[ni][kk] = *(const bf16x8*)(Qb + (size_t)(b * SEQ + q0 + ni * 16 + fr) * 1024 + hd * 64 + kk * 32 + fq * 8);
                f32x4 oacc[4][2];
#pragma unroll
                for (int di = 0; di < 4; ++di) { oacc[di][0] = (f32x4){0.f, 0.f, 0.f, 0.f}; oacc[di][1] = oacc[di][0]; }
                float R[2] = {0.f, 0.f};
                for (int kb = qb * 2 + 1; kb >= 0; --kb) {
                    __syncthreads();
#pragma unroll
                    for (int i = 0; i < 2; ++i) {
                        const int id = tid + i * 256, r = id >> 3, kc = (id & 7) * 8;
                        *(uint4*)(KS + r * 72 + kc) = *(const uint4*)(Kb + (size_t)(b * SEQ + kb * 64 + r) * 1024 + hd * 64 + kc);
                        *(uint4*)(VS + r * 72 + kc) = *(const uint4*)(VT + ((size_t)(b * 16 + hd) * 64 + r) * SEQ + kb * 64 + kc);
                    }
                    __syncthreads();
                    f32x4 st[4][2];
#pragma unroll
                    for (int mi = 0; mi < 4; ++mi) { st[mi][0] = (f32x4){0.f, 0.f, 0.f, 0.f}; st[mi][1] = st[mi][0]; }
#pragma unroll
                    for (int kk = 0; kk < 2; ++kk)
#pragma unroll
                        for (int mi = 0; mi < 4; ++mi) {
                            const bf16x8 a = *(const bf16x8*)(KS + (mi * 16 + fr) * 72 + kk * 32 + fq * 8);
                            st[mi][0] = mfma16(a, qf[0][kk], st[mi][0]);
                            st[mi][1] = mfma16(a, qf[1][kk], st[mi][1]);
                        }
#pragma unroll
                    for (int ni = 0; ni < 2; ++ni) {
                        const int qpos = q0 + ni * 16 + fr;
                        float l1[4][4], tot[4];
#pragma unroll
                        for (int mi = 0; mi < 4; ++mi) {
                            tot[mi] = 0.f;
#pragma unroll
                            for (int e = 0; e < 4; ++e) {
                                const int key = kb * 64 + mi * 16 + fq * 4 + e;
                                const float z = st[mi][ni][e];
                                const float sp = fmaxf(z, 0.f) + __logf(1.f + __expf(-fabsf(z)));
                                const bool valid = key < qpos;
                                l1[mi][e] = valid ? -sp : 0.f;
                                st[mi][ni][e] = valid ? (z - sp) : -1e30f;
                                tot[mi] += l1[mi][e];
                            }
                        }
                        float run = R[ni];
                        float blk = 0.f;
#pragma unroll
                        for (int mi = 3; mi >= 0; --mi) {
                            const float t1 = __shfl_xor(tot[mi], 16), t2 = __shfl_xor(tot[mi], 32), t3 = __shfl_xor(tot[mi], 48);
                            float hi = 0.f;
                            hi += ((fq ^ 1) > fq) ? t1 : 0.f;
                            hi += ((fq ^ 2) > fq) ? t2 : 0.f;
                            hi += ((fq ^ 3) > fq) ? t3 : 0.f;
                            float after = run + hi;
#pragma unroll
                            for (int e = 3; e >= 0; --e) {
                                st[mi][ni][e] = __expf(st[mi][ni][e] + after);
                                after += l1[mi][e];
                            }
                            const float all = tot[mi] + t1 + t2 + t3;
                            run += all;
                            blk += all;
                        }
                        R[ni] += blk;
                    }
#pragma unroll
                    for (int m2 = 0; m2 < 2; ++m2) {
                        bf16x8 pf[2];
#pragma unroll
                        for (int ni = 0; ni < 2; ++ni) {
                            const uint2 lo = pack4(st[2 * m2][ni]), hi = pack4(st[2 * m2 + 1][ni]);
                            const uint4 u = make_uint4(lo.x, lo.y, hi.x, hi.y);
                            pf[ni] = *(const bf16x8*)&u;
                        }
#pragma unroll
                        for (int di = 0; di < 4; ++di) {
                            const uint2 va = *(const uint2*)(VS + (di * 16 + fr) * 72 + (2 * m2) * 16 + fq * 4);
                            const uint2 vb = *(const uint2*)(VS + (di * 16 + fr) * 72 + (2 * m2 + 1) * 16 + fq * 4);
                            const uint4 u = make_uint4(va.x, va.y, vb.x, vb.y);
                            const bf16x8 vf = *(const bf16x8*)&u;
                            oacc[di][0] = mfma16(vf, pf[0], oacc[di][0]);
                            oacc[di][1] = mfma16(vf, pf[1], oacc[di][1]);
                        }
                    }
                    const float wm_ = wmax(fmaxf(R[0], R[1]));
                    if (lane == 0) red[wv] = wm_;
                    __syncthreads();
                    const float mx = fmaxf(fmaxf(red[0], red[1]), fmaxf(red[2], red[3]));
                    if (mx < -120.f) break;
                }
#pragma unroll
                for (int di = 0; di < 4; ++di)
#pragma unroll
                    for (int ni = 0; ni < 2; ++ni)
                        *(uint2*)(OA + (size_t)(b * SEQ + q0 + ni * 16 + fr) * 1024 + hd * 64 + di * 16 + fq * 4) = pack4(oacc[di][ni]);
            }
        }
#endif
        GSYNC;
        {
            GA g = ga_make(OA, 1024, WTM + 3072 * 1024, 1024, TOK, 1024, 1024);
            EpiResid e{PRE, p.out, MOD + 3 * 12288 + 2048};
            gemm_phase(g, e, smem);
        }
        GSYNC;
        mixer_ln(p, 3, PRE);
        GSYNC;
    }
    ffn_layer(p, 3, p.out, xb, smem, true);
}

extern "C" void kernel_launch(void* const* d_in, const int* in_sizes, int n_in, void* d_out, int out_size, void* d_ws, size_t ws_size,
                              hipStream_t stream) {
    static int grid_blocks = 0;
    if (!grid_blocks) {
        int dev = 0, cus = 0, per_cu = 0;
        hipGetDevice(&dev);
        hipDeviceGetAttribute(&cus, hipDeviceAttributeMultiprocessorCount, dev);
        hipOccupancyMaxActiveBlocksPerMultiprocessor(&per_cu, mega, 256, 0);
        if (per_cu > 2) per_cu = 2;
        grid_blocks = cus * per_cu;
    }
    if (ws_size < WS_NEED) { fprintf(stderr, "workspace too small: %zu < %zu\n", ws_size, (size_t)WS_NEED); return; }
    P p{};
    const float** pp = (const float**)&p;
    for (int i = 0; i < 28; ++i) pp[i] = (const float*)d_in[i];
    p.out = (float*)d_out;
    p.ws = (char*)d_ws;
    hipMemsetAsync((char*)d_ws + OFF_BAR, 0, XCD_BAR_WORDS * sizeof(unsigned), stream);
    void* args[] = {&p};
    hipError_t e = hipLaunchCooperativeKernel((void*)mega, dim3(grid_blocks), dim3(256), args, 0, stream);
    if (e != hipSuccess) fprintf(stderr, "cooperative launch failed: %s (grid %d)\n", hipGetErrorString(e), grid_blocks);
}
```
